# Optimizing an MI355X kernel written in HIP

```python
import math
import jax, jax.numpy as jnp
from jax import lax
import numpy as np

D_MODEL = 1024
BATCH = 8
SEQ = 4096
DEPTH = 4

GRID_W = 64
CTX_LEN = 256
N_MIXERS = 2
N_ATTN = (DEPTH + N_MIXERS - 1) // N_MIXERS
N_RET = DEPTH // N_MIXERS
DA_HEADS = 8
DA_HEAD_DIM = D_MODEL // (2 * DA_HEADS)
RET_HEADS = 4
RET_QK_DIM = D_MODEL // RET_HEADS
RET_V_DIM = 2 * RET_QK_DIM
RET_V_WIDTH = RET_HEADS * RET_V_DIM
D_FF = 4 * D_MODEL
Q_BLOCK = 128
RET_CHUNK = 128
ROPE_BASE = 10000.0
NORM_EPS = 1e-6
N_MOD = 6

kernel_name = "hybrid_diffattn_retention_dit"


def rms_norm(x, eps=NORM_EPS):
    xf = x.astype(jnp.float32)
    return (xf * lax.rsqrt(jnp.mean(xf * xf, axis=-1, keepdims=True) + eps)).astype(x.dtype)


def modulate(x, shift, scale):
    return rms_norm(x) * (1.0 + scale) + shift


def _rotate_half(x, ang):
    x1, x2 = jnp.split(x, 2, axis=-1)
    cos = jnp.cos(ang).astype(x.dtype)
    sin = jnp.sin(ang).astype(x.dtype)
    return jnp.concatenate([x1 * cos - x2 * sin, x1 * sin + x2 * cos], axis=-1)


def axial_rope(x):
    n, d = x.shape[-2], x.shape[-1]
    rows = n // GRID_W
    row = jnp.repeat(jnp.arange(rows), GRID_W).astype(jnp.float32)
    col = jnp.tile(jnp.arange(GRID_W), rows).astype(jnp.float32)
    quarter = d // 4
    inv = ROPE_BASE ** (-jnp.arange(quarter, dtype=jnp.float32) / quarter)
    half = d // 2
    xr = _rotate_half(x[..., :half], row[:, None] * inv)
    xc = _rotate_half(x[..., half:], col[:, None] * inv)
    return jnp.concatenate([xr, xc], axis=-1)


def diff_attention(u, uc, w_qkv, w_o, lam, subln_g, lambda_init, need_ctx):
    H, dh = DA_HEADS, DA_HEAD_DIM

    def proj(z):
        b, n, _ = z.shape
        q, k, v = jnp.split(z @ w_qkv, 3, axis=-1)
        q = q.reshape(b, n, H, 2, dh).transpose(0, 2, 3, 1, 4)
        k = k.reshape(b, n, H, 2, dh).transpose(0, 2, 3, 1, 4)
        v = v.reshape(b, n, H, 2 * dh).transpose(0, 2, 1, 3)
        return q, k, v

    q, k, v = proj(u)
    qc, kc, vc = proj(uc)
    q = axial_rope(q)
    k = axial_rope(k)
    lam_f = lam.astype(jnp.float32)
    lam_full = (jnp.exp(jnp.sum(lam_f[0] * lam_f[1])) - jnp.exp(jnp.sum(lam_f[2] * lam_f[3]))
                + lambda_init)
    scale = dh ** -0.5

    def attend(qb, kk, vv):
        s = jnp.einsum('bhiqd,bhikd->bhiqk', qb, kk).astype(jnp.float32) * scale
        p = jax.nn.softmax(s, axis=-1).astype(vv.dtype)
        o = jnp.einsum('bhiqk,bhkv->bhiqv', p, vv)
        return o[:, :, 0] - lam_full.astype(o.dtype) * o[:, :, 1]

    def finish(o):
        b, _, n, _ = o.shape
        o = rms_norm(o) * subln_g * (1.0 - lambda_init)
        return o.transpose(0, 2, 1, 3).reshape(b, n, H * 2 * dh) @ w_o

    B, _, _, S, _ = q.shape
    k_all = jnp.concatenate([k, kc], axis=3)
    v_all = jnp.concatenate([v, vc], axis=2)
    nb = S // Q_BLOCK
    qb = q.reshape(B, H, 2, nb, Q_BLOCK, dh).transpose(3, 0, 1, 2, 4, 5)
    o = lax.map(lambda blk: attend(blk, k_all, v_all), qb)
    o = o.transpose(1, 2, 0, 3, 4).reshape(B, H, S, 2 * dh)
    y = finish(o)
    yc = finish(attend(qc, kc, vc)) if need_ctx else None
    return y, yc


def retention_scan(q, k, v, log_gamma, state0, strict):
    B, H, n, dk = q.shape
    dv = v.shape[-1]
    C = RET_CHUNK
    nc = n // C
    idx = jnp.arange(C, dtype=jnp.float32)
    diff = idx[:, None] - idx[None, :]
    mask = (diff > 0) if strict else (diff >= 0)
    dmat = jnp.where(mask, jnp.exp(jnp.maximum(diff, 0.0) * log_gamma[:, None, None]), 0.0)
    xi = jnp.exp((idx + 1.0) * log_gamma[:, None])[..., None]
    zeta = jnp.exp((C - 1.0 - idx) * log_gamma[:, None])[..., None]
    g_chunk = jnp.exp(C * log_gamma)[:, None, None]

    def chunks(t):
        return t.astype(jnp.float32).reshape(B, H, nc, C, t.shape[-1]).transpose(2, 0, 1, 3, 4)

    def step(state, blk):
        qc, kc, vc = blk
        inner = jnp.einsum('bhqk,bhkv->bhqv', jnp.einsum('bhqd,bhkd->bhqk', qc, kc) * dmat, vc)
        cross = jnp.einsum('bhqd,bhdv->bhqv', qc, state) * xi
        state = state * g_chunk + jnp.einsum('bhkd,bhkv->bhdv', kc * zeta, vc)
        return state, inner + cross

    state, out = lax.scan(step, state0, (chunks(q), chunks(k), chunks(v)))
    out = out.transpose(1, 2, 0, 3, 4).reshape(B, H, n, dv)
    return out, state


def retention(u, uc, w_in, w_o, decay_logit, need_ctx):
    H, dk, dv = RET_HEADS, RET_QK_DIM, RET_V_DIM
    splits = [H * dk, 2 * H * dk, 2 * H * dk + RET_V_WIDTH]

    def proj(z):
        b, n, _ = z.shape
        q, k, v, g = jnp.split(z @ w_in, splits, axis=-1)
        q = q.reshape(b, n, H, dk).transpose(0, 2, 1, 3)
        k = k.reshape(b, n, H, dk).transpose(0, 2, 1, 3) * (dk ** -0.5)
        v = v.reshape(b, n, H, dv).transpose(0, 2, 1, 3)
        return q, k, v, g

    q, k, v, g = proj(u)
    qc, kc, vc, gc = proj(uc)
    q = axial_rope(q)
    k = axial_rope(k)
    log_gamma = jax.nn.log_sigmoid(decay_logit.astype(jnp.float32))
    B = u.shape[0]
    state0 = jnp.zeros((B, H, dk, dv), jnp.float32)
    flip = lambda t: jnp.flip(t, axis=2)
    oc_f, st_f = retention_scan(qc, kc, vc, log_gamma[0], state0, False)
    o_f, _ = retention_scan(q, k, v, log_gamma[0], st_f, False)
    oc_b, st_b = retention_scan(flip(qc), flip(kc), flip(vc), log_gamma[1], state0, True)
    o_b, _ = retention_scan(flip(q), flip(k), flip(v), log_gamma[1], st_b, True)

    def finish(o, gate):
        b, _, n, _ = o.shape
        mu = jnp.mean(o, axis=-1, keepdims=True)
        var = jnp.mean(jnp.square(o - mu), axis=-1, keepdims=True)
        o = (o - mu) * lax.rsqrt(var + 1e-5)
        o = o.transpose(0, 2, 1, 3).reshape(b, n, RET_V_WIDTH).astype(gate.dtype)
        return (jax.nn.silu(gate) * o) @ w_o

    y = finish(o_f + flip(o_b), g)
    yc = finish(oc_f + flip(oc_b), gc) if need_ctx else None
    return y, yc


def channel_mlp(u, w1, w2):
    return jnp.square(jax.nn.relu(u @ w1)) @ w2


def setup_inputs(seed: int = 0) -> dict:
    key = jax.random.key(seed)
    ks = jax.random.split(key, 20)
    f32 = jnp.float32
    nrm = lambda k, shape, s: jax.random.normal(k, shape, f32) * s
    gam0 = 1.0 - 2.0 ** (-5.0 - jnp.arange(RET_HEADS, dtype=f32))
    logit0 = jnp.log(gam0) - jnp.log1p(-gam0)
    return {
        "x": nrm(ks[0], (BATCH, SEQ, D_MODEL), 1.0),
        "c": nrm(ks[1], (BATCH, D_MODEL), 1.0),
        "ctx": nrm(ks[2], (BATCH, CTX_LEN, D_MODEL), 1.0),
        "c_ctx": nrm(ks[3], (D_MODEL,), 1.0),
        "ada_w": nrm(ks[4], (DEPTH, D_MODEL, N_MOD * D_MODEL), 0.5 * D_MODEL ** -0.5),
        "ada_b": nrm(ks[5], (DEPTH, N_MOD * D_MODEL), 0.02),
        "attn_w_qkv": nrm(ks[6], (N_ATTN, D_MODEL, 3 * D_MODEL), D_MODEL ** -0.5),
        "attn_w_o": nrm(ks[7], (N_ATTN, D_MODEL, D_MODEL), D_MODEL ** -0.5),
        "attn_lambda": nrm(ks[8], (N_ATTN, 4, DA_HEAD_DIM), 0.1),
        "attn_subln_g": 1.0 + nrm(ks[9], (N_ATTN, 2 * DA_HEAD_DIM), 0.02),
        "ret_w_in": nrm(ks[10], (N_RET, D_MODEL, 2 * D_MODEL + 2 * RET_V_WIDTH), D_MODEL ** -0.5),
        "ret_w_o": nrm(ks[11], (N_RET, RET_V_WIDTH, D_MODEL), RET_V_WIDTH ** -0.5),
        "ret_decay_logit": jnp.broadcast_to(logit0, (N_RET, 2, RET_HEADS)) + nrm(ks[12], (N_RET, 2, RET_HEADS), 0.1),
        "mlp_w1": nrm(ks[13], (DEPTH, D_MODEL, D_FF), D_MODEL ** -0.5),
        "mlp_w2": nrm(ks[14], (DEPTH, D_FF, D_MODEL), D_FF ** -0.5),
        "final_norm_g": 1.0 + nrm(ks[15], (D_MODEL,), 0.02),
    }


def reference(x, c, ctx, c_ctx, ada_w, ada_b, attn_w_qkv, attn_w_o, attn_lambda, attn_subln_g,
              ret_w_in, ret_w_o, ret_decay_logit, mlp_w1, mlp_w2, final_norm_g):
    B, _, D = x.shape
    h, hc = x, ctx
    sc = jax.nn.silu(c)
    scc = jax.nn.silu(c_ctx)
    for i in range(DEPTH):
        need_ctx = i < DEPTH - 1
        mod = (sc @ ada_w[i] + ada_b[i]).reshape(B, N_MOD, 1, D)
        mod_c = (scc @ ada_w[i] + ada_b[i]).reshape(N_MOD, D)
        u = modulate(h, mod[:, 0], mod[:, 1])
        uc = modulate(hc, mod_c[0], mod_c[1])
        j = i // N_MIXERS
        if i % N_MIXERS == 0:
            lambda_init = 0.8 - 0.6 * math.exp(-0.3 * i)
            y, yc = diff_attention(u, uc, attn_w_qkv[j], attn_w_o[j], attn_lambda[j],
                                   attn_subln_g[j], lambda_init, need_ctx)
        else:
            y, yc = retention(u, uc, ret_w_in[j], ret_w_o[j], ret_decay_logit[j], need_ctx)
        h = h + mod[:, 2] * y
        h = h + mod[:, 5] * channel_mlp(modulate(h, mod[:, 3], mod[:, 4]), mlp_w1[i], mlp_w2[i])
        if need_ctx:
            hc = hc + mod_c[2] * yc
            hc = hc + mod_c[5] * channel_mlp(modulate(hc, mod_c[3], mod_c[4]), mlp_w1[i], mlp_w2[i])
    return rms_norm(h) * final_norm_g
```

```cpp
#include <hip/hip_runtime.h>
#include <hip/hip_cooperative_groups.h>
#include <cstdio>
#include <cstdint>
namespace cg = cooperative_groups;
namespace pg8 {
#define PG8_LAS __attribute__((address_space(3)))
typedef unsigned short bf16_t;
typedef short bf16x8 __attribute__((ext_vector_type(8)));
typedef float f32x4 __attribute__((ext_vector_type(4)));
typedef unsigned u32x4 __attribute__((ext_vector_type(4)));
constexpr int BM = 256, BK = 64, HALF = 128, HTB = HALF * BK * 2  , STAGE_BYTES = 8 * HTB, NXCD = 8, WGM = 4;

__host__ __device__ __forceinline__ int lds_byte(int r, int c) { const int st = (r >> 4) * 2 + (c >> 5), rr = r & 15, cc = c & 31, ob = rr * 64 + cc * 2; return st * 1024 + (ob ^ (((ob >> 9) & 1) << 5)); }
__host__ __device__ __forceinline__ void stage_rc(int b, int& R, int& C) { const int st = b / 1024, sb = b % 1024, swz = sb ^ (((sb >> 9) & 1) << 5); R = (st >> 1) * 16 + swz / 64; C = (st & 1) * 32 + (swz % 64) / 2; }
__host__ __device__ __forceinline__ int perm32(int rho) { const int n = rho >> 4, i = rho & 15; return 8 * (i >> 2) + 4 * n + (i & 3); }

struct Unit { int pm, pn, kofs, nt, sp; };
struct Gemm { const bf16_t* A; const bf16_t* Bt; int M, N, K; };

struct StaticOrder {
    int nM, nN, nwg, G, c, ntK, nsplit, nextra, mext;
    __host__ __device__ __forceinline__ void init(int M, int N, int G_, int c_) { nM = M / BM; nN = N / BM; nwg = nM * nN; G = G_; c = c_; ntK = 0; nsplit = 0; nextra = 0; mext = 0; }
    __host__ __device__ __forceinline__ bool next(int i, Unit& u) const {
        const long L = (long)i * G + c;
        const bool ext = L >= nwg; const int L2 = (int)(L - nwg);
        if (ext && (nsplit == 0 || L2 >= nextra * nN * nsplit)) return false;
        int pm, pn, kofs = 0, ntu = ntK, sp = -1;
        if (ext) { pm = mext + L2 / (nN * nsplit); pn = (L2 / nsplit) % nN; sp = L2 % nsplit; ntu = ntK / nsplit; kofs = sp * ntu * BK; }
        else {
            int wgid = (int)L; { const int q = nwg / NXCD, r = nwg % NXCD, xcd = wgid % NXCD, off = wgid / NXCD; wgid = (xcd < r ? xcd * (q + 1) : r * (q + 1) + (xcd - r) * q) + off; }
            const int nig = WGM * nN, gid = wgid / nig, fm = gid * WGM, gsz = (nM - fm) < WGM ? (nM - fm) : WGM;
            pm = fm + ((wgid % nig) % gsz); pn = (wgid % nig) / gsz;
        }
        u.pm = pm; u.pn = pn; u.kofs = kofs; u.nt = ntu; u.sp = sp; return true;
    }
    __device__ __forceinline__ void a_ready(const Unit&) const {}
    __device__ __forceinline__ void done(const Unit&) const {}
};

__device__ __forceinline__ unsigned cvt_pk_bf16(float lo, float hi) { unsigned r; asm volatile("v_cvt_pk_bf16_f32 %0, %1, %2" : "=v"(r) : "v"(lo), "v"(hi)); return r; }
typedef float f32x2 __attribute__((ext_vector_type(2)));
template <class Epi, class Sched, bool ALIGN_EPI = false, bool SP2 = false>
__device__ __forceinline__ void gemm_phase(int wave_s, PG8_LAS unsigned char* lds, const Gemm g, const Sched& S, const Epi& E) {
    int tid_; asm volatile("v_mbcnt_lo_u32_b32 %0, -1, 0\n\tv_mbcnt_hi_u32_b32 %0, -1, %0" : "=v"(tid_)); tid_ += wave_s * 64;
    const int tid = tid_, wid = __builtin_amdgcn_readfirstlane(tid >> 6), lane = tid & 63, wr = wid >> 2, wc = wid & 3, fr = lane & 15, fq = lane >> 4;
    const int K = g.K;
    unsigned voffA[2], voffB[2];
#pragma unroll
    for (int i = 0; i < 2; ++i) { int R, C; stage_rc(tid * 16 + i * 8192, R, C); const int Rb = Epi::PERM ? ((R & ~31) + perm32(R & 31)) : R;
        voffA[i] = (unsigned)(R * K + C) * 2u; voffB[i] = (unsigned)(Rb * K + C) * 2u; }
    const size_t kstep = (size_t)(BK * 2);
    const size_t hstep = (size_t)HALF * K * 2;
    const size_t tstep = 2 * hstep;
    const unsigned ldsw = (unsigned)wid * 1024u;
    const int aoff = lds_byte(wr * 64 + fr, fq * 8), boff = lds_byte(wc * 32 + fr, fq * 8);
#define PG8_SA(b, h) (((b) * 2 + (h)) * HTB)
#define PG8_SB(b, h) ((4 + (b) * 2 + (h)) * HTB)
#define PG8_STAGE(bufoff, gbase, voff) do { _Pragma("unroll") for (int _i = 0; _i < 2; ++_i) \
        __builtin_amdgcn_global_load_lds((const unsigned*)((const char*)(gbase) + (voff)[_i]), (PG8_LAS unsigned*)(lds + (bufoff) + ldsw + _i * 8192), 16, 0, 0); } while (0)
#define PG8_LDA(dst, b, h) do { _Pragma("unroll") for (int m = 0; m < 4; ++m) _Pragma("unroll") for (int k = 0; k < 2; ++k) dst[m][k] = *(const PG8_LAS bf16x8*)(lds + PG8_SA(b, h) + aoff + m * 2048 + k * 1024); } while (0)
#define PG8_LDB(dst, b, h) do { _Pragma("unroll") for (int n = 0; n < 2; ++n) _Pragma("unroll") for (int k = 0; k < 2; ++k) dst[n][k] = *(const PG8_LAS bf16x8*)(lds + PG8_SB(b, h) + boff + n * 2048 + k * 1024); } while (0)
#define PG8_MMA(ai, bj, At, Bt) do { __builtin_amdgcn_s_setprio(1); _Pragma("unroll") for (int m = 0; m < 4; ++m) _Pragma("unroll") for (int n = 0; n < 2; ++n) _Pragma("unroll") for (int k = 0; k < 2; ++k) \
        acc[ai][bj][m][n] = __builtin_amdgcn_mfma_f32_16x16x32_bf16(Bt[n][k], At[m][k], acc[ai][bj][m][n], 0, 0, 0); __builtin_amdgcn_s_setprio(0); } while (0)
#define PG8_WAIT_V(n) asm volatile("s_waitcnt vmcnt(" #n ")" ::: "memory")
#define PG8_WAIT_L(n) asm volatile("s_waitcnt lgkmcnt(" #n ")" ::: "memory")
#define PG8_BAR __builtin_amdgcn_s_barrier()
#define PG8_SCHED __builtin_amdgcn_sched_barrier(0)
    Unit cur, nxt; int ui = 0;
    if (!S.next(0, cur)) return;
    f32x4 acc[2][2][4][2];
#pragma unroll
    for (int a = 0; a < 2; ++a)
#pragma unroll
        for (int b = 0; b < 2; ++b)
#pragma unroll
            for (int m = 0; m < 4; ++m)
#pragma unroll
                for (int n = 0; n < 2; ++n) acc[a][b][m][n] = (f32x4){0.f, 0.f, 0.f, 0.f};
    bf16x8 At[4][2], B0[2][2], B1[2][2];
    const char* cA = (const char*)g.A + (size_t)cur.pm * tstep + (size_t)cur.kofs * 2; const char* cB = (const char*)g.Bt + (size_t)cur.pn * tstep + (size_t)cur.kofs * 2;
    S.a_ready(cur);
    if constexpr (SP2) {
        PG8_STAGE(PG8_SB(0, 0), cB, voffB); PG8_STAGE(PG8_SB(0, 1), cB + hstep, voffB); PG8_STAGE(PG8_SA(0, 0), cA, voffA); PG8_STAGE(PG8_SA(0, 1), cA + hstep, voffA);
        if (wr == 1) PG8_BAR;
        PG8_WAIT_V(2); PG8_BAR;
        PG8_STAGE(PG8_SB(1, 0), cB + kstep, voffB); PG8_STAGE(PG8_SA(1, 0), cA + kstep, voffA); PG8_STAGE(PG8_SB(1, 1), cB + hstep + kstep, voffB);
        PG8_WAIT_V(6); PG8_BAR;
    } else {
        PG8_STAGE(PG8_SB(0, 0), cB, voffB); PG8_STAGE(PG8_SA(0, 0), cA, voffA); PG8_STAGE(PG8_SB(0, 1), cB + hstep, voffB); PG8_STAGE(PG8_SA(0, 1), cA + hstep, voffA);
        if (wr == 1) PG8_BAR;
        PG8_WAIT_V(4); PG8_BAR;
        PG8_STAGE(PG8_SB(1, 0), cB + kstep, voffB); PG8_STAGE(PG8_SA(1, 0), cA + kstep, voffA); PG8_STAGE(PG8_SB(1, 1), cB + hstep + kstep, voffB);
        PG8_WAIT_V(6); PG8_BAR;
    }
    for (;;) {
        const bool has_next = S.next(ui + 1, nxt);
        const char* nA = has_next ? (const char*)g.A + (size_t)nxt.pm * tstep + (size_t)nxt.kofs * 2 : cA; const char* nB = has_next ? (const char*)g.Bt + (size_t)nxt.pn * tstep + (size_t)nxt.kofs * 2 : cB;
        const int nt = cur.nt;
        for (int t = 0; t < nt; t += 2) {
            const bool last = (t == nt - 2);
            const char* a1 = cA + (size_t)(t + 1) * kstep;
            const char* a2 = last ? nA : cA + (size_t)(t + 2) * kstep; const char* b2 = last ? nB : cB + (size_t)(t + 2) * kstep;
            const char* a3 = a2 + kstep; const char* b3 = b2 + kstep;
            if (last && has_next) S.a_ready(nxt);
            if constexpr (SP2) {
            PG8_LDB(B0, 0, 0); PG8_LDB(B1, 0, 1); PG8_SCHED; PG8_LDA(At, 0, 0); PG8_STAGE(PG8_SA(1, 1), a1 + hstep, voffA);
            PG8_WAIT_V(8); PG8_WAIT_L(0); PG8_BAR; PG8_MMA(0, 0, At, B0); PG8_MMA(0, 1, At, B1); PG8_BAR; PG8_SCHED;
            PG8_LDA(At, 0, 1); PG8_STAGE(PG8_SB(0, 0), b2, voffB); PG8_STAGE(PG8_SB(0, 1), b2 + hstep, voffB); PG8_STAGE(PG8_SA(0, 0), a2, voffA);
            PG8_WAIT_V(8); PG8_WAIT_L(0); PG8_BAR; PG8_MMA(1, 0, At, B0); PG8_MMA(1, 1, At, B1); PG8_BAR; PG8_SCHED;
            PG8_LDB(B0, 1, 0); PG8_LDB(B1, 1, 1); PG8_SCHED; PG8_LDA(At, 1, 0); PG8_STAGE(PG8_SA(0, 1), a2 + hstep, voffA);
            PG8_WAIT_V(8); PG8_WAIT_L(0); PG8_BAR; PG8_MMA(0, 0, At, B0); PG8_MMA(0, 1, At, B1); PG8_BAR; PG8_SCHED;
            PG8_LDA(At, 1, 1); PG8_STAGE(PG8_SB(1, 0), b3, voffB); PG8_STAGE(PG8_SB(1, 1), b3 + hstep, voffB); PG8_STAGE(PG8_SA(1, 0), a3, voffA);
            PG8_WAIT_V(8); PG8_WAIT_L(0); PG8_BAR; PG8_MMA(1, 0, At, B0); PG8_MMA(1, 1, At, B1); PG8_BAR; PG8_SCHED;
            } else {
            PG8_LDB(B0, 0, 0); PG8_SCHED; PG8_LDA(At, 0, 0); PG8_STAGE(PG8_SA(1, 1), a1 + hstep, voffA);
            PG8_WAIT_L(8); PG8_BAR; PG8_WAIT_L(0); PG8_MMA(0, 0, At, B0); PG8_BAR; PG8_SCHED;
            PG8_LDB(B1, 0, 1); PG8_STAGE(PG8_SB(0, 0), b2, voffB);
            PG8_BAR; PG8_WAIT_L(0); PG8_MMA(0, 1, At, B1); PG8_BAR;
            PG8_LDA(At, 0, 1); PG8_STAGE(PG8_SA(0, 0), a2, voffA);
            PG8_BAR; PG8_WAIT_L(0); PG8_MMA(1, 0, At, B0); PG8_BAR; PG8_SCHED;
            PG8_STAGE(PG8_SB(0, 1), b2 + hstep, voffB);
            PG8_WAIT_V(6); PG8_BAR; PG8_MMA(1, 1, At, B1); PG8_BAR;
            PG8_LDB(B0, 1, 0); PG8_SCHED; PG8_LDA(At, 1, 0); PG8_STAGE(PG8_SA(0, 1), a2 + hstep, voffA);
            PG8_WAIT_L(8); PG8_BAR; PG8_WAIT_L(0); PG8_MMA(0, 0, At, B0); PG8_BAR; PG8_SCHED;
            PG8_LDB(B1, 1, 1); PG8_STAGE(PG8_SB(1, 0), b3, voffB);
            PG8_BAR; PG8_WAIT_L(0); PG8_MMA(0, 1, At, B1); PG8_BAR;
            PG8_LDA(At, 1, 1); PG8_STAGE(PG8_SA(1, 0), a3, voffA);
            PG8_BAR; PG8_WAIT_L(0); PG8_MMA(1, 0, At, B0); PG8_BAR; PG8_SCHED;
            PG8_STAGE(PG8_SB(1, 1), b3 + hstep, voffB);
            PG8_WAIT_V(6); PG8_BAR; PG8_MMA(1, 1, At, B1); PG8_BAR;
            }
        }
        if constexpr (ALIGN_EPI) { if (wr == 0) PG8_BAR; }
        if constexpr (!Epi::AFTER_DRAIN) { E(acc, cur, wr, wc, fr, fq); S.done(cur); }
        if (!has_next) break;
#pragma unroll
        for (int a = 0; a < 2; ++a)
#pragma unroll
            for (int b = 0; b < 2; ++b)
#pragma unroll
                for (int m = 0; m < 4; ++m)
#pragma unroll
                    for (int n = 0; n < 2; ++n) acc[a][b][m][n] = (f32x4){0.f, 0.f, 0.f, 0.f};
        cur = nxt; cA = nA; cB = nB; ++ui;
        if constexpr (ALIGN_EPI) { if (wr == 1) PG8_BAR; }
    }
    PG8_WAIT_V(0);
    if constexpr (!ALIGN_EPI) { if (wr == 0) PG8_BAR; }
    PG8_BAR;
    if constexpr (Epi::AFTER_DRAIN) { E.fused(acc, cur, wr, wc, fr, fq, lds, wid, lane); S.done(cur); }
#undef PG8_SA
#undef PG8_SB
#undef PG8_STAGE
#undef PG8_LDA
#undef PG8_LDB
#undef PG8_MMA
#undef PG8_WAIT_V
#undef PG8_WAIT_L
#undef PG8_BAR
#undef PG8_SCHED
}
}

constexpr int BATCH = 8, SEQ = 4096, DM = 1024, CTXL = 256, DEPTH = 4;
constexpr int RLAT = BATCH * SEQ, RCTX = BATCH * CTXL, RALL = RLAT + RCTX;
constexpr int KEYS = SEQ + CTXL;
constexpr int DFF = 4096, NMODC = 6 * DM;
constexpr float NORM_EPS = 1e-6f;
constexpr float QSCALE = 0.125f * 1.4426950408889634f;

constexpr size_t MiB = 1u << 20;
constexpr size_t WS_MOD = 0;
constexpr size_t WS_BAR = 960 * 1024;
constexpr size_t WS_ROPE = 1 * MiB;
constexpr size_t WS_W = 2 * MiB;
constexpr size_t WS_U = 18 * MiB;
constexpr size_t WS_Q = 86 * MiB;
constexpr size_t WS_K = 154 * MiB;
constexpr size_t WS_V = 222 * MiB;
constexpr size_t WS_O = 358 * MiB;
constexpr size_t WS_HC = 494 * MiB;
constexpr size_t WS_END = 502 * MiB;
constexpr size_t WS_HID = WS_K;
constexpr int LDS_BYTES = 147456;

#define LAS __attribute__((address_space(3)))
typedef unsigned short bf16_t;
typedef short bf16x8 __attribute__((ext_vector_type(8)));
typedef float f32x4 __attribute__((ext_vector_type(4)));
typedef float f32x16 __attribute__((ext_vector_type(16)));
typedef unsigned u32x4 __attribute__((ext_vector_type(4)));
typedef unsigned u32x2 __attribute__((ext_vector_type(2)));

__device__ __forceinline__ unsigned pk2(float lo, float hi) { typedef float f2_t __attribute__((ext_vector_type(2))); typedef __bf16 b2_t __attribute__((ext_vector_type(2))); f2_t v = {lo, hi}; b2_t b = __builtin_convertvector(v, b2_t); return __builtin_bit_cast(unsigned, b); }
__device__ __forceinline__ bf16_t f2bf(float f) { return (bf16_t)(pk2(f, 0.f) & 0xffffu); }
__device__ __forceinline__ float bflo(unsigned w) { return __uint_as_float(w << 16); }
__device__ __forceinline__ float bfhi(unsigned w) { return __uint_as_float(w & 0xffff0000u); }
__device__ __forceinline__ u32x4 pack8(f32x4 lo, f32x4 hi) { u32x4 w; w.x = pk2(lo[0], lo[1]); w.y = pk2(lo[2], lo[3]); w.z = pk2(hi[0], hi[1]); w.w = pk2(hi[2], hi[3]); return w; }
__device__ __forceinline__ u32x4 scale8(u32x4 w, float s) { u32x4 o; o.x = pk2(bflo(w.x) * s, bfhi(w.x) * s); o.y = pk2(bflo(w.y) * s, bfhi(w.y) * s); o.z = pk2(bflo(w.z) * s, bfhi(w.z) * s); o.w = pk2(bflo(w.w) * s, bfhi(w.w) * s); return o; }
__device__ __forceinline__ float xor32_sum(float v) { const auto r = __builtin_amdgcn_permlane32_swap(__float_as_uint(v), __float_as_uint(v), false, false); return __uint_as_float(r[0]) + __uint_as_float(r[1]); }
__device__ __forceinline__ float xor32_max(float v) { const auto r = __builtin_amdgcn_permlane32_swap(__float_as_uint(v), __float_as_uint(v), false, false); return __builtin_fmaxf(__uint_as_float(r[0]), __uint_as_float(r[1])); }
__device__ __forceinline__ float xor16_sum(float v) { const auto r = __builtin_amdgcn_permlane16_swap(__float_as_uint(v), __float_as_uint(v), false, false); return __uint_as_float(r[0]) + __uint_as_float(r[1]); }
template <int CTRL> __device__ __forceinline__ float dpp_sum(float v) { return v + __uint_as_float(__builtin_amdgcn_update_dpp(0u, __float_as_uint(v), CTRL, 0xf, 0xf, true)); }
__device__ __forceinline__ float wave_sum(float v) {
    v = dpp_sum<0xB1>(v);
    v = dpp_sum<0x4E>(v);
    v = dpp_sum<0x141>(v);
    v = dpp_sum<0x140>(v);
    v = xor16_sum(v);
    return xor32_sum(v);
}
__device__ __forceinline__ float silu_f(float x) { return x * __builtin_amdgcn_rcpf(1.0f + __expf(-x)); }
__device__ __forceinline__ f32x16 mfma32(bf16x8 a, bf16x8 b, f32x16 c) { return __builtin_amdgcn_mfma_f32_32x32x16_bf16(a, b, c, 0, 0, 0); }
__device__ __forceinline__ int kappa(int m) { return (m & ~12) | ((m & 4) << 1) | ((m & 8) >> 1); }
__device__ __forceinline__ void rope8(f32x4& lo, f32x4& hi, const f32x4 c, const f32x4 s) {
    float a, b;
    a = lo[0]; b = lo[1]; lo[0] = a * c[0] - b * s[0]; lo[1] = a * s[0] + b * c[0];
    a = lo[2]; b = lo[3]; lo[2] = a * c[1] - b * s[1]; lo[3] = a * s[1] + b * c[1];
    a = hi[0]; b = hi[1]; hi[0] = a * c[2] - b * s[2]; hi[1] = a * s[2] + b * c[2];
    a = hi[2]; b = hi[3]; hi[2] = a * c[3] - b * s[3]; hi[3] = a * s[3] + b * c[3];
}

struct Ids { int tid, lane, wave, vcu, G; };
__device__ __forceinline__ int hw_lane() { int l; asm volatile("v_mbcnt_lo_u32_b32 %0, -1, 0\n\tv_mbcnt_hi_u32_b32 %0, -1, %0" : "=v"(l)); return l; }
__device__ __forceinline__ int hw_tid(int wave_s) { return wave_s * 64 + hw_lane(); }
__device__ __forceinline__ Ids make_ids(int wave_s) {
    Ids I; int t = hw_tid(wave_s); asm volatile("" : "+v"(t));
    I.tid = t; I.lane = t & 63; I.wave = __builtin_amdgcn_readfirstlane(t >> 6); I.G = gridDim.x;
    const int bx = blockIdx.x; I.vcu = (I.G % 8 == 0) ? (bx % 8) * (I.G / 8) + bx / 8 : bx;
    return I;
}

struct EpiP {
    bf16_t* o0; bf16_t* o1; bf16_t* o2;
    const float* rc; const float* rs;
    const float* hin_l; const float* hin_c; float* hout_l; float* hout_c; const float* gate;
    float* part;
};
template <int MODE> struct Epi {
    static constexpr bool PERM = true, AFTER_DRAIN = false;
    EpiP p;
    __device__ __forceinline__ void operator()(const pg8::f32x4 (&acc)[2][2][4][2], const pg8::Unit& u, int wr, int wc, int fr, int fq) const {
        const int upm = u.pm, upn = u.pn, usp = u.sp;
#pragma unroll
        for (int ai = 0; ai < 2; ++ai)
#pragma unroll
            for (int m = 0; m < 4; ++m) {
                int fr_ = fr; asm volatile("" : "+v"(fr_) :: "memory");
                const int row = upm * 256 + ai * 128 + wr * 64 + m * 16 + fr_;
                const bool lat = row < RLAT;
                int b, pos;
                if (lat) { b = row >> 12; pos = row & (SEQ - 1); } else { const int r2 = row - RLAT; b = r2 >> 8; pos = SEQ + (r2 & (CTXL - 1)); }
#pragma unroll
                for (int bj = 0; bj < 2; ++bj) {
                    const int c = upn * 256 + bj * 128 + wc * 32 + 8 * fq;
                    f32x4 lo = acc[ai][bj][m][0], hi = acc[ai][bj][m][1];
                    if constexpr (MODE == 0) {
                        const int sec = c >> 10;
                        if (sec < 2) {
                            const int cc = c & 1023, head = cc >> 7, i = (cc >> 6) & 1, pp = cc & 63;
                            if (lat) { const int pidx = (pp < 32) ? (pos >> 6) : (pos & 63); const int j0 = (pp & 31) >> 1;
                                const f32x4 cs = *(const f32x4*)(p.rc + pidx * 16 + j0), sn = *(const f32x4*)(p.rs + pidx * 16 + j0); rope8(lo, hi, cs, sn); }
                            if (sec == 0) { lo = lo * QSCALE; hi = hi * QSCALE; }
                            bf16_t* dst = (sec == 0 ? p.o0 : p.o1) + ((size_t)((b * 8 + head) * 2 + i) * KEYS + pos) * 64 + pp;
                            *(u32x4*)dst = pack8(lo, hi);
                        } else {
                            const int cc = c - 2048, head = cc >> 7, dv = cc & 127;
                            bf16_t* dst = p.o2 + ((size_t)((b * 8 + head) * 128 + dv)) * KEYS + pos;
                            dst[0] = f2bf(lo[0]); dst[KEYS] = f2bf(lo[1]); dst[2 * KEYS] = f2bf(lo[2]); dst[3 * KEYS] = f2bf(lo[3]);
                            dst[4 * KEYS] = f2bf(hi[0]); dst[5 * KEYS] = f2bf(hi[1]); dst[6 * KEYS] = f2bf(hi[2]); dst[7 * KEYS] = f2bf(hi[3]);
                        }
                    } else if constexpr (MODE == 1) {
                        if (c < 2048) {
                            const int sec = c >> 10, cc = c & 1023, pp = cc & 255;
                            if (lat && p.rc) {
                                const float pf = (float)((pp < 128) ? (pos >> 6) : (pos & 63)); const int j0 = (pp & 127) >> 1;
                                const f32x4 rv = *(const f32x4*)(p.rc + j0) * pf; f32x4 cs, sn;
#pragma unroll
                                for (int t = 0; t < 4; ++t) { cs[t] = __builtin_amdgcn_cosf(rv[t]); sn[t] = __builtin_amdgcn_sinf(rv[t]); }
                                rope8(lo, hi, cs, sn); }
                            if (sec == 1) { lo = lo * 0.0625f; hi = hi * 0.0625f; }
                            bf16_t* dst = (sec == 0 ? p.o0 : p.o1) + (size_t)row * 1024 + cc;
                            *(u32x4*)dst = pack8(lo, hi);
                        } else {
                            bf16_t* dst = p.o2 + (size_t)row * 2048 + (c - 2048);
                            *(u32x4*)dst = pack8(lo, hi);
                        }
                    } else if constexpr (MODE == 2) {
                        if (usp >= 0) {
                            float* pp = p.part + ((size_t)usp * RCTX + (size_t)(row - RLAT)) * DM + c;
                            *(f32x4*)pp = lo; *(f32x4*)(pp + 4) = hi;
                        } else {
                        const float* hin; float* hout; int bidx;
                        if (lat) { hin = p.hin_l + (size_t)row * DM; hout = p.hout_l + (size_t)row * DM; bidx = b; }
                        else { const size_t r2 = (size_t)(row - RLAT); hin = p.hin_c + r2 * DM; hout = p.hout_c + r2 * DM; bidx = 8; }
                        const float* g = p.gate + bidx * NMODC + c;
                        const f32x4 g0 = *(const f32x4*)g, g1 = *(const f32x4*)(g + 4), h0 = *(const f32x4*)(hin + c), h1 = *(const f32x4*)(hin + c + 4);
                        *(f32x4*)(hout + c) = h0 + g0 * lo; *(f32x4*)(hout + c + 4) = h1 + g1 * hi;
                        }
                    } else if constexpr (MODE == 3) {
#pragma unroll
                        for (int j = 0; j < 4; ++j) { const float a = __builtin_amdgcn_fmed3f(lo[j], 0.f, __builtin_inff()), d = __builtin_amdgcn_fmed3f(hi[j], 0.f, __builtin_inff()); lo[j] = a * a; hi[j] = d * d; }
                        *(u32x4*)(p.o0 + (size_t)row * DFF + c) = pack8(lo, hi);
                    } else {
                        bf16_t* dst = p.o0 + (size_t)row * 2048 + c;
                        const u32x4 w = *(const u32x4*)dst;
                        lo[0] = silu_f(lo[0]) * bflo(w.x); lo[1] = silu_f(lo[1]) * bfhi(w.x); lo[2] = silu_f(lo[2]) * bflo(w.y); lo[3] = silu_f(lo[3]) * bfhi(w.y);
                        hi[0] = silu_f(hi[0]) * bflo(w.z); hi[1] = silu_f(hi[1]) * bfhi(w.z); hi[2] = silu_f(hi[2]) * bflo(w.w); hi[3] = silu_f(hi[3]) * bfhi(w.w);
                        *(u32x4*)dst = pack8(lo, hi);
                    }
                }
                asm volatile("" ::: "memory");
            }
    }
};

template <int MODE> __device__ __forceinline__ void run_gemm(int wave_s, LAS unsigned char* lds, const bf16_t* A, const bf16_t* Bt, int M, int N, int K, const EpiP& ep, bool split_ctx = false) {
    pg8::Gemm g{A, Bt, M, N, K}; pg8::StaticOrder S; S.init(split_ctx ? RLAT : M, N, (int)gridDim.x, (int)blockIdx.x); S.ntK = K / 64;
    if (split_ctx) { S.nsplit = 4; S.nextra = RCTX / 256; S.mext = RLAT / 256; }
    Epi<MODE> E{ep};
    pg8::gemm_phase<Epi<MODE>, pg8::StaticOrder, true, true>(wave_s, lds, g, S, E);
}

__device__ __forceinline__ int srccol(int mode, int n) {
    if (mode == 1 && n < 2048) { const int base = n & ~63, p = n & 63, half = p >> 5, q = p & 31, j = q >> 1; return base + half * 32 + ((q & 1) ? j + 16 : j); }
    if (mode == 2 && n < 2048) { const int base = n & ~255, p = n & 255, half = p >> 7, q = p & 127, j = q >> 1; return base + half * 128 + ((q & 1) ? j + 64 : j); }
    return n;
}
__device__ __forceinline__ void conv_item(const float* W, int K, int N, bf16_t* WT, int mode, LAS float* scr, int item, int lane) {
    const int nblk = N / 32, kb = item / nblk, nb = item % nblk, k0 = 64 * kb, n0 = 32 * nb;
    const int sc = srccol(mode, n0 + (lane & 31));
#pragma unroll 8
    for (int i = 0; i < 32; ++i) { const int kk = 2 * i + (lane >> 5); scr[kk * 33 + (lane & 31)] = W[(size_t)(k0 + kk) * N + sc]; }
    asm volatile("s_waitcnt lgkmcnt(0)" ::: "memory");
    const int c = lane & 7;
#pragma unroll
    for (int j = 0; j < 4; ++j) { const int n = (lane >> 3) + 8 * j; const LAS float* s = scr + (8 * c) * 33 + n;
        u32x4 o; o.x = pk2(s[0 * 33], s[1 * 33]); o.y = pk2(s[2 * 33], s[3 * 33]); o.z = pk2(s[4 * 33], s[5 * 33]); o.w = pk2(s[6 * 33], s[7 * 33]);
        *(u32x4*)(WT + (size_t)(n0 + n) * K + k0 + 8 * c) = o; }
    asm volatile("s_waitcnt lgkmcnt(0)" ::: "memory");
}
__device__ __forceinline__ void conv_two(int wave_s, LAS unsigned char* lds, const float* W0, int K0, int N0, bf16_t* T0, int mode0, const float* W1, int K1, int N1, bf16_t* T1, int first_block = 0) {
    const Ids I = make_ids(wave_s);
    LAS float* scr = (LAS float*)(lds + I.wave * 16384);
    if ((int)blockIdx.x < first_block) return;
    const int gw = (first_block ? (int)blockIdx.x - first_block : I.vcu) * 8 + I.wave, NGW = (I.G - first_block) * 8;
    const int n0 = (K0 / 64) * (N0 / 32), n1 = (K1 / 64) * (N1 / 32);
    for (int it = gw; it < n0 + n1; it += NGW) {
        if (it < n0) conv_item(W0, K0, N0, T0, mode0, scr, it, I.lane);
        else conv_item(W1, K1, N1, T1, 0, scr, it - n0, I.lane);
    }
}

__device__ __forceinline__ void norm_rows(int wave_s, const float* hl, const float* hc, const float* modL, int shoff, int scoff, bf16_t* U, int nrows, const float* part = nullptr, const float* gate_c = nullptr, float* hc_out = nullptr) {
    const Ids I = make_ids(wave_s);
    const int gw = I.vcu * 8 + I.wave, NGW = I.G * 8;
    for (int grp = gw; grp < RLAT / 4; grp += NGW) {
        const int row0 = grp * 4, bidx = row0 >> 12;
        const float* src = hl + (size_t)row0 * DM + 4 * I.lane;
        const float* sh = modL + bidx * NMODC + shoff + 4 * I.lane; const float* sc = modL + bidx * NMODC + scoff + 4 * I.lane;
        f32x4 v[4][4];
#pragma unroll
        for (int r = 0; r < 4; ++r)
#pragma unroll
            for (int j = 0; j < 4; ++j) v[r][j] = *(const f32x4*)(src + r * DM + 256 * j);
        float rstd[4];
#pragma unroll
        for (int r = 0; r < 4; ++r) { float s = 0.f;
#pragma unroll
            for (int j = 0; j < 4; ++j) s += (v[r][j][0] * v[r][j][0] + v[r][j][1] * v[r][j][1]) + (v[r][j][2] * v[r][j][2] + v[r][j][3] * v[r][j][3]);
            rstd[r] = rsqrtf(wave_sum(s) * (1.0f / DM) + NORM_EPS); }
#pragma unroll
        for (int j = 0; j < 4; ++j) { const f32x4 a = *(const f32x4*)(sc + 256 * j) + 1.0f, bs = *(const f32x4*)(sh + 256 * j);
#pragma unroll
            for (int r = 0; r < 4; ++r) { const f32x4 o = v[r][j] * rstd[r] * a + bs; u32x2 w; w.x = pk2(o[0], o[1]); w.y = pk2(o[2], o[3]); *(u32x2*)(U + (size_t)(row0 + r) * DM + 4 * I.lane + 256 * j) = w; } }
    }
    for (int row = RLAT + gw; row < nrows; row += NGW) {
        const float* src = hc + (size_t)(row - RLAT) * DM;
        const float* sh = modL + 8 * NMODC + shoff; const float* sc = modL + 8 * NMODC + scoff;
        f32x4 v[4]; float s = 0.f;
#pragma unroll
        for (int j = 0; j < 4; ++j) { const int c = 4 * I.lane + 256 * j; v[j] = *(const f32x4*)(src + c);
            if (part) { const float* pp = part + (size_t)(row - RLAT) * DM + c; const size_t ps = (size_t)RCTX * DM;
                const f32x4 ps4 = (*(const f32x4*)pp + *(const f32x4*)(pp + ps)) + (*(const f32x4*)(pp + 2 * ps) + *(const f32x4*)(pp + 3 * ps));
                v[j] = v[j] + *(const f32x4*)(gate_c + c) * ps4; *(f32x4*)(hc_out + (size_t)(row - RLAT) * DM + c) = v[j]; }
            s += (v[j][0] * v[j][0] + v[j][1] * v[j][1]) + (v[j][2] * v[j][2] + v[j][3] * v[j][3]); }
        const float rstd = rsqrtf(wave_sum(s) * (1.0f / DM) + NORM_EPS);
#pragma unroll
        for (int j = 0; j < 4; ++j) { const int c = 4 * I.lane + 256 * j; const f32x4 a = *(const f32x4*)(sc + c), bs = *(const f32x4*)(sh + c);
            const f32x4 o = v[j] * rstd * (a + 1.0f) + bs; u32x2 w; w.x = pk2(o[0], o[1]); w.y = pk2(o[2], o[3]); *(u32x2*)(U + (size_t)row * DM + c) = w; }
    }
}
__device__ __forceinline__ void final_norm(int wave_s, float* h, const float* g) {
    const Ids I = make_ids(wave_s);
    const int gw = I.vcu * 8 + I.wave, NGW = I.G * 8;
    for (int grp = gw; grp < RLAT / 4; grp += NGW) {
        float* src = h + (size_t)grp * 4 * DM + 4 * I.lane;
        f32x4 v[4][4];
#pragma unroll
        for (int r = 0; r < 4; ++r)
#pragma unroll
            for (int j = 0; j < 4; ++j) v[r][j] = *(const f32x4*)(src + r * DM + 256 * j);
        float rstd[4];
#pragma unroll
        for (int r = 0; r < 4; ++r) { float s = 0.f;
#pragma unroll
            for (int j = 0; j < 4; ++j) s += (v[r][j][0] * v[r][j][0] + v[r][j][1] * v[r][j][1]) + (v[r][j][2] * v[r][j][2] + v[r][j][3] * v[r][j][3]);
            rstd[r] = rsqrtf(wave_sum(s) * (1.0f / DM) + NORM_EPS); }
#pragma unroll
        for (int j = 0; j < 4; ++j) { const f32x4 a = *(const f32x4*)(g + 4 * I.lane + 256 * j);
#pragma unroll
            for (int r = 0; r < 4; ++r) *(f32x4*)(src + r * DM + 256 * j) = v[r][j] * rstd[r] * a; }
    }
}
__device__ __forceinline__ void gn_rows(int wave_s, bf16_t* O, int nrows) {
    const Ids I = make_ids(wave_s);
    const int gw = I.vcu * 8 + I.wave, NGW = I.G * 8;
    for (int grp = gw; grp < nrows / 4; grp += NGW) {
        bf16_t* p0 = O + (size_t)grp * 4 * 2048 + I.lane * 8;
        u32x4 w[4][4];
#pragma unroll
        for (int r = 0; r < 4; ++r)
#pragma unroll
            for (int hd = 0; hd < 4; ++hd) w[r][hd] = *(const u32x4*)(p0 + r * 2048 + hd * 512);
#pragma unroll
        for (int r = 0; r < 4; ++r)
#pragma unroll
            for (int hd = 0; hd < 4; ++hd) {
                const u32x4 ww = w[r][hd];
                float x0 = bflo(ww.x), x1 = bfhi(ww.x), x2 = bflo(ww.y), x3 = bfhi(ww.y), x4 = bflo(ww.z), x5 = bfhi(ww.z), x6 = bflo(ww.w), x7 = bfhi(ww.w);
                const float mean = wave_sum(((x0 + x1) + (x2 + x3)) + ((x4 + x5) + (x6 + x7))) * (1.0f / 512.0f);
                x0 -= mean; x1 -= mean; x2 -= mean; x3 -= mean; x4 -= mean; x5 -= mean; x6 -= mean; x7 -= mean;
                const float var = wave_sum(((x0 * x0 + x1 * x1) + (x2 * x2 + x3 * x3)) + ((x4 * x4 + x5 * x5) + (x6 * x6 + x7 * x7))) * (1.0f / 512.0f);
                const float rstd = rsqrtf(var + 1e-5f);
                u32x4 o; o.x = pk2(x0 * rstd, x1 * rstd); o.y = pk2(x2 * rstd, x3 * rstd); o.z = pk2(x4 * rstd, x5 * rstd); o.w = pk2(x6 * rstd, x7 * rstd);
                *(u32x4*)(p0 + r * 2048 + hd * 512) = o;
            }
    }
}

__device__ __forceinline__ void ada_phase(int wave_s, LAS unsigned char* lds, const float* c, const float* cctx, const float* ada_w, const float* ada_b, float* MOD) {
    const Ids I = make_ids(wave_s);
    LAS float* sl = (LAS float*)lds;
    LAS float* red = sl + 9 * 1024;
    for (int idx = I.tid; idx < 9 * 1024; idx += 512) { const int r = idx >> 10, k = idx & 1023; const float x = r < 8 ? c[r * 1024 + k] : cctx[k]; sl[idx] = silu_f(x); }
    __syncthreads();
    const int cgx = I.tid & 7, ks = I.tid >> 3;
    for (int item = blockIdx.x; item < 4 * 192; item += gridDim.x) {
        const int l = item / 192, n0 = (item % 192) * 32;
        f32x4 a0 = {0.f, 0.f, 0.f, 0.f}, a1 = a0, a2 = a0, a3 = a0, a4 = a0, a5 = a0, a6 = a0, a7 = a0, a8 = a0;
        const float* wp = ada_w + ((size_t)l * 1024 + ks * 16) * NMODC + n0 + 4 * cgx;
        const LAS float* sp = sl + ks * 16;
#pragma unroll 8
        for (int kk = 0; kk < 16; ++kk) {
            const f32x4 w = *(const f32x4*)(wp + (size_t)kk * NMODC);
            a0 += w * sp[kk]; a1 += w * sp[1024 + kk]; a2 += w * sp[2048 + kk]; a3 += w * sp[3072 + kk]; a4 += w * sp[4096 + kk];
            a5 += w * sp[5120 + kk]; a6 += w * sp[6144 + kk]; a7 += w * sp[7168 + kk]; a8 += w * sp[8192 + kk];
        }
        LAS f32x4* rp = (LAS f32x4*)(red + (ks * 8 + cgx) * 36);
        rp[0] = a0; rp[1] = a1; rp[2] = a2; rp[3] = a3; rp[4] = a4; rp[5] = a5; rp[6] = a6; rp[7] = a7; rp[8] = a8;
        __syncthreads();
        for (int o = I.tid; o < 288; o += 512) {
            const int r = o >> 5, col = o & 31, cg2 = col >> 2, j = col & 3; float s = 0.f;
            for (int k2 = 0; k2 < 64; ++k2) s += red[(k2 * 8 + cg2) * 36 + r * 4 + j];
            MOD[(size_t)(l * 9 + r) * NMODC + n0 + col] = s + ada_b[l * NMODC + n0 + col];
        }
        __syncthreads();
    }
}
__device__ __forceinline__ void rope_tables(float* T) {
    const int g = blockIdx.x * 512 + threadIdx.x;
    if (g < 64) T[10240 + g] = exp2f(-(float)g * (1.0f / 64.0f) * 13.287712379549449f) * 0.15915494309189535f;
    if (g < 1024 + 4096) {
        int pos, j; float e; float* cp; float* sp;
        if (g < 1024) { pos = g >> 4; j = g & 15; e = (float)j * (1.0f / 16.0f); cp = T + g; sp = T + 1024 + g; }
        else { const int g2 = g - 1024; pos = g2 >> 6; j = g2 & 63; e = (float)j * (1.0f / 64.0f); cp = T + 2048 + g2; sp = T + 2048 + 4096 + g2; }
        const float inv = exp2f(-e * 13.287712379549449f);
        const float ang = (float)pos * inv;
        const float n = rintf(ang * 0.15915494309189535f);
        float r = fmaf(-n, 6.2831854820251465f, ang); r = fmaf(-n, -1.7484555e-07f, r);
        *cp = __builtin_amdgcn_cosf(r * 0.15915494309189535f); *sp = __builtin_amdgcn_sinf(r * 0.15915494309189535f);
    }
}

__device__ __forceinline__ void attn_phase(int wave_s, LAS unsigned char* lds, const bf16_t* QA, const bf16_t* KA, const bf16_t* VT, bf16_t* OA, const float* lam, const float* subg, float lambda_init, bool need_ctx) {
    const Ids I = make_ids(wave_s);
    const int tid = I.tid, lane = I.lane, wave = I.wave, r32 = lane & 31, hi = lane >> 5, map = wave >> 2, wq = wave & 3;
    float s01 = 0.f, s23 = 0.f;
    for (int d = 0; d < 64; ++d) { s01 += lam[d] * lam[64 + d]; s23 += lam[128 + d] * lam[192 + d]; }
    const float lam_full = __expf(s01) - __expf(s23) + lambda_init;
    const float osc = 1.0f - lambda_init;
    const int nunits = 2048 + (need_ctx ? 128 : 0);
    constexpr int STG = 36864;
    const int krow = tid >> 3, kch = tid & 7;
    const int kro = kappa(r32) * 144 + hi * 16;
    for (int u = I.vcu; u < nunits; u += I.G) {
        int bh, q0, key0, nt, tok0;
        if (u < 2048) { bh = u >> 5; const int qb = u & 31; q0 = qb * 128; key0 = 0; nt = KEYS / 64; tok0 = (bh >> 3) * SEQ + q0; }
        else { const int v = u - 2048; bh = v >> 1; const int qb = v & 1; q0 = SEQ + qb * 128; key0 = SEQ; nt = CTXL / 64; tok0 = RLAT + (bh >> 3) * CTXL + qb * 128; }
        const int h = bh & 7;
        const bf16_t* qp = QA + ((size_t)(bh * 2 + map) * KEYS + q0 + wq * 32 + r32) * 64 + hi * 8;
        bf16x8 qf[4];
#pragma unroll
        for (int ks = 0; ks < 4; ++ks) qf[ks] = *(const bf16x8*)(qp + ks * 16);
        const bf16_t* k0p = KA + ((size_t)(bh * 2 + 0) * KEYS + key0 + krow) * 64 + kch * 8;
        const bf16_t* k1p = KA + ((size_t)(bh * 2 + 1) * KEYS + key0 + krow) * 64 + kch * 8;
        const bf16_t* v0p = VT + ((size_t)bh * 128 + krow) * KEYS + key0 + kch * 8;
        const bf16_t* v1p = v0p + (size_t)64 * KEYS;
        const int rot = (u < 2048) ? ((u & 31) * 2) : ((u & 1) * 2);
        u32x4 sk0 = *(const u32x4*)(k0p + (size_t)rot * 4096), sk1 = *(const u32x4*)(k1p + (size_t)rot * 4096), sv0 = *(const u32x4*)(v0p + rot * 64), sv1 = *(const u32x4*)(v1p + rot * 64);
#define ATT_WRITE(stoff) do { LAS unsigned char* sb_ = lds + (stoff) + krow * 144 + kch * 16; *(LAS u32x4*)(sb_) = sk0; *(LAS u32x4*)(sb_ + 9216) = sk1; *(LAS u32x4*)(sb_ + 18432) = sv0; *(LAS u32x4*)(sb_ + 18432 + 9216) = sv1; } while (0)
#define ATT_LOAD(tt) do { sk0 = *(const u32x4*)(k0p + (size_t)(tt) * 4096); sk1 = *(const u32x4*)(k1p + (size_t)(tt) * 4096); sv0 = *(const u32x4*)(v0p + (tt) * 64); sv1 = *(const u32x4*)(v1p + (tt) * 64); } while (0)
#define ATT_QK(P0, P1, stoff) do { const LAS unsigned char* kb_ = lds + (stoff) + map * 9216 + kro; \
            _Pragma("unroll") for (int r = 0; r < 16; ++r) { P0[r] = 0.f; P1[r] = 0.f; } \
            _Pragma("unroll") for (int ks = 0; ks < 4; ++ks) { const bf16x8 a0 = *(const LAS bf16x8*)(kb_ + ks * 32), a1 = *(const LAS bf16x8*)(kb_ + 32 * 144 + ks * 32); \
                P0 = mfma32(a0, qf[ks], P0); P1 = mfma32(a1, qf[ks], P1); } } while (0)
        f32x16 O[4];
        typedef float f32x8 __attribute__((ext_vector_type(8)));
        f32x8 lv8;
        volatile LAS unsigned* aflag = (volatile LAS unsigned*)(lds + LDS_BYTES - 64);
#define ATT_TILES(FAST) \
        for (int t = 0; t < nt; ++t) { \
            const int s0 = (t & 1) * STG, s1 = STG - s0; \
            ATT_WRITE(s1); \
            { int tl = t + 2 < nt ? t + 2 : nt - 1; tl += rot; tl = tl < nt ? tl : tl - nt; ATT_LOAD(tl); } \
            f32x16 pc0, pc1; \
            ATT_QK(pc0, pc1, s0); \
            if (!(FAST) && t == 0) { float m0 = __builtin_fmaxf(pc0[0], pc1[0]); \
                _Pragma("unroll") for (int r = 1; r < 16; ++r) m0 = __builtin_fmaxf(m0, __builtin_fmaxf(pc0[r], pc1[r])); \
                mref = xor32_max(m0); } \
            const LAS unsigned char* vb = lds + s0 + 18432 + r32 * 144 + hi * 16; \
            bf16x8 vf0 = *(const LAS bf16x8*)(vb), vf1 = *(const LAS bf16x8*)(vb + 32 * 144), vf2 = *(const LAS bf16x8*)(vb + 64 * 144), vf3 = *(const LAS bf16x8*)(vb + 96 * 144); \
            if (!(FAST)) { \
                pc0 = pc0 - mref; pc1 = pc1 - mref; \
                float mx = __builtin_fmaxf(__builtin_fmaxf(pc0[0], pc1[0]), pc0[1]); \
                mx = __builtin_fmaxf(__builtin_fmaxf(mx, pc1[1]), pc0[2]); \
                _Pragma("unroll") for (int r = 2; r < 15; ++r) mx = __builtin_fmaxf(__builtin_fmaxf(mx, pc1[r]), pc0[r + 1]); \
                mx = __builtin_fmaxf(mx, pc1[15]); \
                mx = xor32_max(mx); \
                if (__any(mx > 8.0f)) { \
                    const float dl = __builtin_fmaxf(mx, 0.f); mref += dl; pc0 = pc0 - dl; pc1 = pc1 - dl; \
                    const float alpha = __builtin_amdgcn_exp2f(-dl); lv8 = lv8 * alpha; \
                    _Pragma("unroll") for (int d = 0; d < 4; ++d) O[d] = O[d] * alpha; \
                } \
            } \
            _Pragma("unroll") for (int s = 0; s < 4; ++s) { \
                bf16x8 vn0 = vf0, vn1 = vf1, vn2 = vf2, vn3 = vf3; \
                if (s < 3) { vn0 = *(const LAS bf16x8*)(vb + (s + 1) * 32); vn1 = *(const LAS bf16x8*)(vb + 32 * 144 + (s + 1) * 32); vn2 = *(const LAS bf16x8*)(vb + 64 * 144 + (s + 1) * 32); vn3 = *(const LAS bf16x8*)(vb + 96 * 144 + (s + 1) * 32); } \
                f32x8 e; \
                _Pragma("unroll") for (int j = 0; j < 8; ++j) e[j] = __builtin_amdgcn_exp2f(s < 2 ? pc0[8 * s + j] : pc1[8 * (s - 2) + j]); \
                lv8 = lv8 + e; \
                u32x4 w; w.x = pk2(e[0], e[1]); w.y = pk2(e[2], e[3]); w.z = pk2(e[4], e[5]); w.w = pk2(e[6], e[7]); \
                const bf16x8 pb = __builtin_bit_cast(bf16x8, w); \
                O[0] = mfma32(vf0, pb, O[0]); O[1] = mfma32(vf1, pb, O[1]); O[2] = mfma32(vf2, pb, O[2]); O[3] = mfma32(vf3, pb, O[3]); \
                vf0 = vn0; vf1 = vn1; vf2 = vn2; vf3 = vn3; \
            } \
            __syncthreads(); \
        }
        float lsum = 0.f;
        for (int pass = 0; pass < 2; ++pass) {
            if (pass == 1) ATT_LOAD(rot);
            ATT_WRITE(0);
            ATT_LOAD(rot + 1 < nt ? rot + 1 : rot + 1 - nt);
            __syncthreads();
#pragma unroll
            for (int d = 0; d < 4; ++d)
#pragma unroll
                for (int r = 0; r < 16; ++r) O[d][r] = 0.f;
#pragma unroll
            for (int r = 0; r < 8; ++r) lv8[r] = 0.f;
            float mref = 0.f;
            if (pass == 0) { ATT_TILES(true) } else { ATT_TILES(false) }
            lsum = xor32_sum(((lv8[0] + lv8[1]) + (lv8[2] + lv8[3])) + ((lv8[4] + lv8[5]) + (lv8[6] + lv8[7])));
            if (pass == 1) break;
            const bool bad = !(lsum > 1e-30f && lsum < 1e30f);
            const unsigned wbad = __any(bad) ? 1u : 0u;
            if (lane == 0) aflag[wave] = wbad;
            __syncthreads();
            const unsigned any8 = aflag[0] | aflag[1] | aflag[2] | aflag[3] | aflag[4] | aflag[5] | aflag[6] | aflag[7];
            __syncthreads();
            if (any8 == 0u) break;
        }
#undef ATT_TILES
#undef ATT_WRITE
#undef ATT_LOAD
#undef ATT_QK
        const float inv = __builtin_amdgcn_rcpf(lsum);
        LAS float* X = (LAS float*)lds;
        const int xr = wq * 32 + r32;
        if (map == 1) {
#pragma unroll
            for (int d = 0; d < 4; ++d)
#pragma unroll
                for (int g = 0; g < 4; ++g) { f32x4 v = {O[d][4 * g] * inv, O[d][4 * g + 1] * inv, O[d][4 * g + 2] * inv, O[d][4 * g + 3] * inv}; *(LAS f32x4*)(X + xr * 132 + 32 * d + 8 * g + 4 * hi) = v; }
        }
        __syncthreads();
        if (map == 0) {
            float ss = 0.f;
#pragma unroll
            for (int d = 0; d < 4; ++d)
#pragma unroll
                for (int g = 0; g < 4; ++g) { const f32x4 o1 = *(const LAS f32x4*)(X + xr * 132 + 32 * d + 8 * g + 4 * hi);
#pragma unroll
                    for (int j = 0; j < 4; ++j) { const float df = O[d][4 * g + j] * inv - lam_full * o1[j]; O[d][4 * g + j] = df; ss += df * df; } }
            ss = xor32_sum(ss);
            const float rn = rsqrtf(ss * (1.0f / 128.0f) + NORM_EPS) * osc;
            bf16_t* op = OA + (size_t)(tok0 + xr) * DM + h * 128 + 4 * hi;
#pragma unroll
            for (int d = 0; d < 4; ++d)
#pragma unroll
                for (int g = 0; g < 4; ++g) { const int cdv = 32 * d + 8 * g; const f32x4 gg = *(const f32x4*)(subg + cdv + 4 * hi);
                    u32x2 w; w.x = pk2(O[d][4 * g] * rn * gg[0], O[d][4 * g + 1] * rn * gg[1]); w.y = pk2(O[d][4 * g + 2] * rn * gg[2], O[d][4 * g + 3] * rn * gg[3]);
                    *(u32x2*)(op + cdv) = w; }
        }
        __syncthreads();
    }
}

constexpr int SC_QD = 0, SC_KD = 18432, SC_BUF = 36864, SC_SQ = 0, SC_VS = 73728, SC_ST = 92160, SC_END = 125952;
static_assert(SC_END <= LDS_BYTES, "scan LDS map");
__device__ __forceinline__ int scan_row0(int step, int dir, int b) {
    if (step < 2) { const int c = dir == 0 ? step : 1 - step; return RLAT + b * CTXL + c * 128; }
    const int c = dir == 0 ? step - 2 : 33 - step; return b * SEQ + c * 128;
}
typedef short s16x4_t __attribute__((ext_vector_type(4)));
__device__ __forceinline__ bf16x8 tr_frag(const LAS unsigned char* p) {
    const s16x4_t lo = __builtin_bit_cast(s16x4_t, __builtin_amdgcn_ds_read_tr16_b64_v4i16((LAS s16x4_t*)p));
    const s16x4_t hi = __builtin_bit_cast(s16x4_t, __builtin_amdgcn_ds_read_tr16_b64_v4i16((LAS s16x4_t*)(p + 4 * 144)));
    return (bf16x8){lo[0], lo[1], lo[2], lo[3], hi[0], hi[1], hi[2], hi[3]};
}
__device__ __forceinline__ void st16(LAS unsigned char* p, unsigned v) { *(LAS unsigned short*)p = (unsigned short)v; }
__device__ __forceinline__ void tr_write8(LAS unsigned char* base, u32x4 w) {
    st16(base, w.x & 0xffffu); st16(base + 272, w.x >> 16); st16(base + 2 * 272, w.y & 0xffffu); st16(base + 3 * 272, w.y >> 16);
    st16(base + 4 * 272, w.z & 0xffffu); st16(base + 5 * 272, w.z >> 16); st16(base + 6 * 272, w.w & 0xffffu); st16(base + 7 * 272, w.w >> 16);
}
__device__ __forceinline__ void scan_phase(int wave_s, LAS unsigned char* lds, const bf16_t* QR, const bf16_t* KR, const bf16_t* VR, bf16_t* O, const float* dlogit) {
    const Ids I = make_ids(wave_s);
    const int tid = I.tid, lane = I.lane, wave = I.wave, r32 = lane & 31, hi = lane >> 5;
    const int qb = wave & 3, dvb = wave >> 2, sdv = wave & 1, sdb0 = wave >> 1;
    const int srow = tid >> 3, sch = tid & 7;
    const int qloc = 32 * qb + r32;
    const int trb = (hi * 8 + ((lane & 15) >> 2)) * 144 + (((lane >> 4) & 1) * 16 + (lane & 3) * 4) * 2;
    for (int u = I.vcu; u < 256; u += I.G) {
        const int slice = u & 7, h = (u >> 3) & 3, b = u >> 5;
        for (int dir = 0; dir < 2; ++dir) {
            const float lg2 = -__log2f(1.0f + __expf(-dlogit[dir * 4 + h]));
            const float gC = exp2f(128.0f * lg2);
            const float e0 = dir == 0 ? (float)(127 - srow) : (float)srow, e1 = dir == 0 ? (float)(63 - srow) : (float)(srow + 64);
            const float vz0 = exp2f(lg2 * e0), vz1 = exp2f(lg2 * e1);
            const float fin = exp2f(lg2 * (dir == 0 ? (float)(qloc - 127) : (float)(-qloc)));
            for (int i = tid; i < (SC_END - SC_ST) / 16; i += 512) *(LAS u32x4*)(lds + SC_ST + i * 16) = (u32x4){0u, 0u, 0u, 0u};
            f32x16 st0, st1, sa0, sa1, ca;
#pragma unroll
            for (int r = 0; r < 16; ++r) { st0[r] = 0.f; st1[r] = 0.f; sa0[r] = 0.f; sa1[r] = 0.f; ca[r] = 0.f; }
            int row0 = scan_row0(0, dir, b);
            const size_t qoff = (size_t)srow * 1024 + h * 256 + sch * 8, voff = (size_t)srow * 2048 + h * 512 + slice * 64 + sch * 8;
            u32x4 gq0, gq1, gk0, gk1, gv0, gv1, go0 = {0u, 0u, 0u, 0u}, go1 = go0;
            { const bf16_t* qp = QR + (size_t)row0 * 1024 + qoff; const bf16_t* kp = KR + (size_t)row0 * 1024 + qoff; const bf16_t* vp = VR + (size_t)row0 * 2048 + voff;
              gq0 = *(const u32x4*)qp; gq1 = *(const u32x4*)(qp + 64 * 1024); gk0 = *(const u32x4*)kp; gk1 = *(const u32x4*)(kp + 64 * 1024); gv0 = *(const u32x4*)vp; gv1 = *(const u32x4*)(vp + 64 * 2048); }
            for (int step = 0; step < 34; ++step) {
                const int row_next = scan_row0(step + 1 < 34 ? step + 1 : step, dir, b);
#pragma unroll
                for (int dc = 0; dc < 4; ++dc) {
                    { const u32x4 a0 = gq0, a1 = gq1, b0 = gk0, b1 = gk1;
                      LAS unsigned char* qd = lds + (dc & 1) * SC_BUF + SC_QD + srow * 144 + sch * 16; *(LAS u32x4*)qd = a0; *(LAS u32x4*)(qd + 64 * 144) = a1;
                      LAS unsigned char* kd = lds + (dc & 1) * SC_BUF + SC_KD + srow * 144 + sch * 16; *(LAS u32x4*)kd = b0; *(LAS u32x4*)(kd + 64 * 144) = b1;
                      if (dc == 0) { LAS unsigned char* vd = lds + SC_VS + srow * 144 + sch * 16; *(LAS u32x4*)vd = scale8(gv0, vz0); *(LAS u32x4*)(vd + 64 * 144) = scale8(gv1, vz1); } }
                    __syncthreads();
                    if (dc == 0 && dir == 1) { const bf16_t* op = O + (size_t)(row0 + srow) * 2048 + h * 512 + slice * 64 + sch * 8; go0 = *(const u32x4*)op; go1 = *(const u32x4*)(op + (size_t)64 * 2048); }
                    if (dc < 3) { const bf16_t* qp = QR + (size_t)row0 * 1024 + qoff + (dc + 1) * 64; const bf16_t* kp = KR + (size_t)row0 * 1024 + qoff + (dc + 1) * 64;
                        gq0 = *(const u32x4*)qp; gq1 = *(const u32x4*)(qp + 64 * 1024); gk0 = *(const u32x4*)kp; gk1 = *(const u32x4*)(kp + 64 * 1024); }
                    else { const bf16_t* qp = QR + (size_t)row_next * 1024 + qoff; const bf16_t* kp = KR + (size_t)row_next * 1024 + qoff; const bf16_t* vp = VR + (size_t)row_next * 2048 + voff;
                        gq0 = *(const u32x4*)qp; gq1 = *(const u32x4*)(qp + 64 * 1024); gk0 = *(const u32x4*)kp; gk1 = *(const u32x4*)(kp + 64 * 1024); gv0 = *(const u32x4*)vp; gv1 = *(const u32x4*)(vp + 64 * 2048); }
                    bf16x8 bq[4];
#pragma unroll
                    for (int ks = 0; ks < 4; ++ks) bq[ks] = *(const LAS bf16x8*)(lds + (dc & 1) * SC_BUF + SC_QD + qloc * 144 + ks * 32 + hi * 16);
#pragma unroll
                    for (int ks = 0; ks < 4; ++ks) {
                        const bf16x8 k0 = *(const LAS bf16x8*)(lds + (dc & 1) * SC_BUF + SC_KD + (64 * dvb + kappa(r32)) * 144 + ks * 32 + hi * 16);
                        const bf16x8 k1 = *(const LAS bf16x8*)(lds + (dc & 1) * SC_BUF + SC_KD + (64 * dvb + 32 + kappa(r32)) * 144 + ks * 32 + hi * 16);
                        const bf16x8 sf = *(const LAS bf16x8*)(lds + SC_ST + (32 * dvb + r32) * 528 + (64 * dc + 16 * ks + 8 * hi) * 2);
                        sa0 = mfma32(k0, bq[ks], sa0); sa1 = mfma32(k1, bq[ks], sa1); ca = mfma32(sf, bq[ks], ca);
                    }
                    if ((dc & 1) == dvb) {
                        f32x16 s = (dc < 2) ? st0 : st1;
                        s = s * gC;
                        const LAS unsigned char* ka = lds + (dc & 1) * SC_BUF + SC_KD + trb + (sdb0 & 1) * 64;
                        const LAS unsigned char* va = lds + SC_VS + trb + sdv * 64;
                        f32x16 s2;
#pragma unroll
                        for (int r = 0; r < 16; ++r) s2[r] = 0.f;
#pragma unroll
                        for (int ks = 0; ks < 8; ks += 2) { const bf16x8 a = tr_frag(ka + ks * 16 * 144), bv = tr_frag(va + ks * 16 * 144), a2 = tr_frag(ka + (ks + 1) * 16 * 144), bv2 = tr_frag(va + (ks + 1) * 16 * 144);
                            s = mfma32(a, bv, s); s2 = mfma32(a2, bv2, s2); }
                        s = s + s2;
                        if (dc < 2) st0 = s; else st1 = s;
                    }
                }
#pragma unroll
                for (int x = 0; x < 2; ++x)
#pragma unroll
                    for (int s2 = 0; s2 < 2; ++s2) {
                        const int key0 = 64 * dvb + 32 * x + 16 * s2 + 8 * hi; float v[8];
#pragma unroll
                        for (int e = 0; e < 8; ++e) { const float sv = x == 0 ? sa0[8 * s2 + e] : sa1[8 * s2 + e]; const bool keep = dir == 0 ? (key0 + e <= qloc) : (key0 + e > qloc); v[e] = keep ? sv : 0.f; }
                        u32x4 w; w.x = pk2(v[0], v[1]); w.y = pk2(v[2], v[3]); w.z = pk2(v[4], v[5]); w.w = pk2(v[6], v[7]);
                        *(LAS u32x4*)(lds + SC_SQ + qloc * 272 + key0 * 2) = w;
                    }
                ca = ca * gC;
                __syncthreads();
#pragma unroll
                for (int x = 0; x < 2; ++x)
#pragma unroll
                    for (int g = 0; g < 4; ++g) { const int d = 32 * (sdb0 + 4 * x) + 8 * g + 4 * hi; u32x2 w;
                        if (x == 0) { w.x = pk2(st0[4 * g], st0[4 * g + 1]); w.y = pk2(st0[4 * g + 2], st0[4 * g + 3]); } else { w.x = pk2(st1[4 * g], st1[4 * g + 1]); w.y = pk2(st1[4 * g + 2], st1[4 * g + 3]); }
                        *(LAS u32x2*)(lds + SC_ST + (32 * sdv + r32) * 528 + d * 2) = w; }
                { const LAS unsigned char* va = lds + SC_VS + trb + dvb * 64;
                  f32x16 c2;
#pragma unroll
                  for (int r = 0; r < 16; ++r) c2[r] = 0.f;
#pragma unroll
                  for (int ks = 0; ks < 8; ks += 2) { const bf16x8 a = tr_frag(va + ks * 16 * 144), a2 = tr_frag(va + (ks + 1) * 16 * 144);
                      const bf16x8 bs = *(const LAS bf16x8*)(lds + SC_SQ + qloc * 272 + ks * 32 + hi * 16), bs2 = *(const LAS bf16x8*)(lds + SC_SQ + qloc * 272 + (ks + 1) * 32 + hi * 16);
                      ca = mfma32(a, bs, ca); c2 = mfma32(a2, bs2, c2); }
                  ca = ca + c2; }
#pragma unroll
                for (int g = 0; g < 4; ++g) { const f32x4 v = {ca[4 * g] * fin, ca[4 * g + 1] * fin, ca[4 * g + 2] * fin, ca[4 * g + 3] * fin}; *(LAS f32x4*)(lds + SC_BUF + qloc * 272 + (32 * dvb + 8 * g + 4 * hi) * 4) = v; }
#pragma unroll
                for (int r = 0; r < 16; ++r) { sa0[r] = 0.f; sa1[r] = 0.f; ca[r] = 0.f; }
                __syncthreads();
                { bf16_t* op = O + (size_t)(row0 + srow) * 2048 + h * 512 + slice * 64 + sch * 8;
                  const LAS unsigned char* os = lds + SC_BUF + srow * 272 + sch * 32;
                  f32x4 x0 = *(const LAS f32x4*)os, x1 = *(const LAS f32x4*)(os + 16), y0 = *(const LAS f32x4*)(os + 64 * 272), y1 = *(const LAS f32x4*)(os + 64 * 272 + 16);
                  if (dir == 1) {
                      x0[0] += bflo(go0.x); x0[1] += bfhi(go0.x); x0[2] += bflo(go0.y); x0[3] += bfhi(go0.y); x1[0] += bflo(go0.z); x1[1] += bfhi(go0.z); x1[2] += bflo(go0.w); x1[3] += bfhi(go0.w);
                      y0[0] += bflo(go1.x); y0[1] += bfhi(go1.x); y0[2] += bflo(go1.y); y0[3] += bfhi(go1.y); y1[0] += bflo(go1.z); y1[1] += bfhi(go1.z); y1[2] += bflo(go1.w); y1[3] += bfhi(go1.w); }
                  *(u32x4*)op = pack8(x0, x1); *(u32x4*)(op + (size_t)64 * 2048) = pack8(y0, y1); }
                row0 = row_next;
            }
        }
    }
}

#define XB_TMO      128
#define XB_XCNT(j)  (256  + 64 * (j))
#define XB_XSUB(j)  (1280 + 64 * (j))
#define XB_XGEN(j)  (2304 + 64 * (j))
#define XB_TOP      3328
#define XB_TOPGEN   3392
#define XCD_BAR_WORDS 3456
#define XB_SPIN_CAP (1u << 21)

__device__ __forceinline__ unsigned xb_ld(unsigned* p)              { return __hip_atomic_load(p, __ATOMIC_RELAXED, __HIP_MEMORY_SCOPE_AGENT); }
__device__ __forceinline__ unsigned xb_add(unsigned* p, unsigned v) { return __hip_atomic_fetch_add(p, v, __ATOMIC_RELAXED, __HIP_MEMORY_SCOPE_AGENT); }
__device__ __forceinline__ unsigned xb_xcc_id() { return (unsigned)__builtin_amdgcn_s_getreg((3 << 11) | 20) & 0xFu; }
#define XB_SPIN(cond, bar) do { unsigned _sp = 0; while (cond) { __builtin_amdgcn_s_sleep(1); \
    if ((++_sp & 255u) == 0u) { if (xb_ld(&(bar)[XB_TMO])) break; if (_sp > XB_SPIN_CAP) { atomicAdd(&(bar)[XB_TMO], 1u); break; } } } } while (0)

struct XcdBarrier {
    unsigned* bar; unsigned x;
    bool w0;
    volatile LAS unsigned* st;
};

__device__ __forceinline__ XcdBarrier xcd_barrier_post(unsigned* bar, volatile LAS unsigned* st) {
    XcdBarrier b; b.bar = bar; b.x = xb_xcc_id(); b.st = st;
    if (threadIdx.x == 0) (void)xb_add(&bar[XB_XCNT(b.x)], 1u);
    return b;
}
__device__ __forceinline__ void xcd_barrier_complete(unsigned* bar, unsigned x, unsigned& nloc, unsigned& nx) {
    const unsigned G = gridDim.x * gridDim.y * gridDim.z;
    unsigned sum, cnt, mine, sp = 0u;
    for (;;) {
        sum = 0u; cnt = 0u; mine = 0u;
#pragma unroll
        for (unsigned j = 0; j < 16; ++j) { const unsigned c = xb_ld(&bar[XB_XCNT(j)]); sum += c; cnt += (c > 0u) ? 1u : 0u; mine = (j == x) ? c : mine; }
        if (sum == G) break;
        __builtin_amdgcn_s_sleep(1);
        if ((++sp & 255u) == 0u) { if (xb_ld(&bar[XB_TMO])) break; if (sp > XB_SPIN_CAP) { atomicAdd(&bar[XB_TMO], 1u); break; } }
    }
    nloc = mine > 0u ? mine : 1u; nx = cnt > 0u ? cnt : 1u;
}

__device__ __forceinline__ void xcd_barrier(const XcdBarrier& b) {
    asm volatile("s_waitcnt vmcnt(0)" ::: "memory");
    __syncthreads();
    if (b.w0 && hw_lane() == 0) {
        unsigned* bar = b.bar;
        __builtin_amdgcn_s_waitcnt(0);
        unsigned nloc = b.st[0], nx = b.st[1];
        const unsigned old = xb_add(&bar[XB_XSUB(b.x)], 1u);
        const unsigned gen = old / nloc;
        if (old + 1u == (gen + 1u) * nloc) {
            __builtin_amdgcn_fence(__ATOMIC_RELEASE, "agent");
            asm volatile("s_waitcnt vmcnt(0)" ::: "memory");
            const unsigned og = xb_add(&bar[XB_TOP], 1u);
            const unsigned tg = og / nx;
            if (og + 1u == (tg + 1u) * nx) xb_add(&bar[XB_TOPGEN], 1u);
            else XB_SPIN(xb_ld(&bar[XB_TOPGEN]) == tg, bar);
            __builtin_amdgcn_fence(__ATOMIC_ACQUIRE, "agent");
            xb_add(&bar[XB_XGEN(b.x)], 1u);
            asm volatile("s_waitcnt vmcnt(0)" ::: "memory");
        } else {
            XB_SPIN(xb_ld(&bar[XB_XGEN(b.x)]) == gen, bar);
            __builtin_amdgcn_fence(__ATOMIC_ACQUIRE, "agent");
            asm volatile("s_waitcnt vmcnt(0)" ::: "memory");
        }
    }
    __syncthreads();
}

struct Args { const float* in[16]; float* out; unsigned char* ws; };
__global__ void __launch_bounds__(512, 2) mega_fwd(Args a) {
    extern __shared__ __attribute__((aligned(16))) unsigned char lds_raw[];
    LAS unsigned char* lds = (LAS unsigned char*)lds_raw;
    cg::grid_group grid = cg::this_grid();
    const int wave_s = __builtin_amdgcn_readfirstlane((int)threadIdx.x >> 6);
    volatile LAS unsigned* bst = (volatile LAS unsigned*)(lds + LDS_BYTES - 16);
    if (threadIdx.x == 0) { bst[0] = 0u; bst[1] = 0u; }
    __syncthreads();
    XcdBarrier bar = xcd_barrier_post((unsigned*)(a.ws + WS_BAR), bst);
    bar.w0 = wave_s == 0;
#define GSYNC() xcd_barrier(bar)
    const float* x = a.in[0]; const float* cvec = a.in[1]; const float* ctx = a.in[2]; const float* cctx = a.in[3]; const float* ada_w = a.in[4]; const float* ada_b = a.in[5];
    const float* w_qkv = a.in[6]; const float* w_ao = a.in[7]; const float* a_lam = a.in[8]; const float* a_subg = a.in[9]; const float* w_rin = a.in[10]; const float* w_ro = a.in[11];
    const float* r_decay = a.in[12]; const float* w_m1 = a.in[13]; const float* w_m2 = a.in[14]; const float* fin_g = a.in[15];
    float* out = a.out; unsigned char* ws = a.ws;
    float* MOD = (float*)(ws + WS_MOD); float* ROPE = (float*)(ws + WS_ROPE);
    bf16_t* WB = (bf16_t*)(ws + WS_W); bf16_t* U = (bf16_t*)(ws + WS_U); bf16_t* QB = (bf16_t*)(ws + WS_Q); bf16_t* KB = (bf16_t*)(ws + WS_K);
    bf16_t* VB = (bf16_t*)(ws + WS_V); bf16_t* OB = (bf16_t*)(ws + WS_O); float* HC = (float*)(ws + WS_HC); bf16_t* HID = (bf16_t*)(ws + WS_HID);
    bf16_t* W1T = QB; bf16_t* W2T = QB + (size_t)DFF * DM;
    float* PART = (float*)(ws + WS_Q + 16 * MiB);

    ada_phase(wave_s, lds, cvec, cctx, ada_w, ada_b, MOD);
    rope_tables(ROPE);
    conv_two(wave_s, lds, w_qkv, DM, 3 * DM, WB, 1, w_ao, DM, DM, WB + (size_t)3 * DM * DM, (int)gridDim.x / 2);
    if (threadIdx.x == 0) { unsigned nloc_, nx_; xcd_barrier_complete(bar.bar, bar.x, nloc_, nx_); bst[0] = nloc_; bst[1] = nx_; }
    __syncthreads();
    if (a.ws == nullptr) grid.sync();
    GSYNC();

    for (int layer = 0; layer < DEPTH; ++layer) {
        const bool is_ret = (layer & 1) != 0; const int j = layer >> 1;
        const bool need_ctx = layer < DEPTH - 1;
        const int Mres = need_ctx ? RALL : RLAT;
        const float* hl_in = layer == 0 ? x : out; const float* hc_in = layer == 0 ? ctx : HC;
        const float* modL = MOD + (size_t)layer * 9 * NMODC;
        EpiP ep{};
        if (layer == 0) norm_rows(wave_s, hl_in, hc_in, modL, 0, DM, U, RALL);
        else norm_rows(wave_s, hl_in, hc_in, modL, 0, DM, U, RALL, PART, MOD + ((size_t)(layer - 1) * 9 + 8) * NMODC + 5 * DM, HC);
        if (!is_ret) { if (layer > 0) conv_two(wave_s, lds, w_qkv + (size_t)j * DM * 3 * DM, DM, 3 * DM, WB, 1, w_ao + (size_t)j * DM * DM, DM, DM, WB + (size_t)3 * DM * DM); }
        else conv_two(wave_s, lds, w_rin + (size_t)j * DM * 6 * DM, DM, 6 * DM, WB, 2, w_ro + (size_t)j * 2 * DM * DM, 2 * DM, DM, WB + (size_t)6 * DM * DM);
        GSYNC();
        if (!is_ret) {
            ep.o0 = QB; ep.o1 = KB; ep.o2 = VB; ep.rc = ROPE; ep.rs = ROPE + 1024;
            run_gemm<0>(wave_s, lds, U, WB, RALL, 3 * DM, DM, ep);
            GSYNC();
            const float lambda_init = layer == 0 ? 0.2f : 0.47071301834358397f;
            attn_phase(wave_s, lds, QB, KB, VB, OB, a_lam + j * 256, a_subg + j * 128, lambda_init, need_ctx);
            GSYNC();
            ep.hin_l = hl_in; ep.hin_c = hc_in; ep.hout_l = out; ep.hout_c = HC; ep.gate = modL + 2 * DM;
            ep.part = PART;
            run_gemm<2>(wave_s, lds, OB, WB + (size_t)3 * DM * DM, Mres, DM, DM, ep, need_ctx);
        } else {
            ep.o0 = QB; ep.o1 = KB; ep.o2 = VB; ep.rc = ROPE + 10240; ep.rs = ROPE + 10240;
            run_gemm<1>(wave_s, lds, U, WB, RALL, 4 * DM, DM, ep);
            GSYNC();
            scan_phase(wave_s, lds, QB, KB, VB, OB, r_decay + j * 8);
            GSYNC();
            gn_rows(wave_s, OB, Mres);
            GSYNC();
            ep.o0 = OB;
            run_gemm<4>(wave_s, lds, U, WB + (size_t)4 * DM * DM, Mres, 2 * DM, DM, ep);
            GSYNC();
            ep.hin_l = hl_in; ep.hin_c = hc_in; ep.hout_l = out; ep.hout_c = HC; ep.gate = modL + 2 * DM;
            ep.part = PART;
            run_gemm<2>(wave_s, lds, OB, WB + (size_t)6 * DM * DM, Mres, DM, 2 * DM, ep, need_ctx);
        }
        GSYNC();
        if (need_ctx) norm_rows(wave_s, out, hc_in, modL, 3 * DM, 4 * DM, U, Mres, PART, modL + 8 * NMODC + 2 * DM, HC);
        else norm_rows(wave_s, out, HC, modL, 3 * DM, 4 * DM, U, Mres);
        conv_two(wave_s, lds, w_m1 + (size_t)layer * DM * DFF, DM, DFF, W1T, 0, w_m2 + (size_t)layer * DFF * DM, DFF, DM, W2T);
        GSYNC();
        ep.o0 = HID;
        run_gemm<3>(wave_s, lds, U, W1T, Mres, DFF, DM, ep);
        GSYNC();
        ep.hin_l = out; ep.hin_c = HC; ep.hout_l = out; ep.hout_c = HC; ep.gate = modL + 5 * DM;
        ep.part = PART;
        run_gemm<2>(wave_s, lds, HID, W2T, Mres, DM, DFF, ep, need_ctx);
        GSYNC();
    }
    final_norm(wave_s, out, fin_g);
}

extern "C" void kernel_launch(void* const* d_in, const int* in_sizes, int n_in, void* d_out, int out_size, void* d_ws, size_t ws_size, hipStream_t stream) {
    static int grid = 0;
    if (grid == 0) {
        if (n_in != 16 || in_sizes[0] != RLAT * DM || out_size != RLAT * DM || ws_size < WS_END) {
            fprintf(stderr, "kernel_launch: unexpected shapes (n_in %d, in0 %d, out %d, ws %zu < %zu); nothing launched\n", n_in, n_in > 0 ? in_sizes[0] : -1, out_size, ws_size, (size_t)WS_END); grid = -1; return; }
        int dev = 0, cus = 0, per_cu = 0;
        if (hipGetDevice(&dev) != hipSuccess || hipDeviceGetAttribute(&cus, hipDeviceAttributeMultiprocessorCount, dev) != hipSuccess) { fprintf(stderr, "kernel_launch: device query failed\n"); grid = -1; return; }
        if (hipFuncSetAttribute((const void*)mega_fwd, hipFuncAttributeMaxDynamicSharedMemorySize, LDS_BYTES) != hipSuccess) { fprintf(stderr, "kernel_launch: hipFuncSetAttribute failed\n"); grid = -1; return; }
        if (hipOccupancyMaxActiveBlocksPerMultiprocessor(&per_cu, (const void*)mega_fwd, 512, LDS_BYTES) != hipSuccess || per_cu < 1) { fprintf(stderr, "kernel_launch: occupancy query says %d blocks per CU\n", per_cu); per_cu = 1; }
        (void)hipGetLastError();
        grid = cus;
    }
    if (grid < 0) return;
    Args a{};
    for (int i = 0; i < 16; ++i) a.in[i] = (const float*)d_in[i];
    a.out = (float*)d_out; a.ws = (unsigned char*)d_ws;
    if (hipMemsetAsync((unsigned char*)d_ws + WS_BAR, 0, 16384, stream) != hipSuccess) { fprintf(stderr, "kernel_launch: hipMemsetAsync failed\n"); return; }
    void* args[] = {&a};
    const hipError_t e = hipLaunchCooperativeKernel((const void*)mega_fwd, dim3(grid), dim3(512), args, LDS_BYTES, stream);
    if (e != hipSuccess) fprintf(stderr, "kernel_launch: cooperative launch failed: %s (grid %d)\n", hipGetErrorString(e), grid);
}
```

```cpp
#include <hip/hip_runtime.h>
#include <hip/hip_cooperative_groups.h>
#include <cstdio>
#include <cstdint>
namespace cg = cooperative_groups;
namespace pg8 {
#define PG8_LAS __attribute__((address_space(3)))
typedef unsigned short bf16_t;
typedef short bf16x8 __attribute__((ext_vector_type(8)));
typedef float f32x4 __attribute__((ext_vector_type(4)));
typedef unsigned u32x4 __attribute__((ext_vector_type(4)));
constexpr int BM = 256, BK = 64, HALF = 128, HTB = HALF * BK * 2  , STAGE_BYTES = 8 * HTB, NXCD = 8, WGM = 4;

__host__ __device__ __forceinline__ int lds_byte(int r, int c) { const int st = (r >> 4) * 2 + (c >> 5), rr = r & 15, cc = c & 31, ob = rr * 64 + cc * 2; return st * 1024 + (ob ^ (((ob >> 9) & 1) << 5)); }
__host__ __device__ __forceinline__ void stage_rc(int b, int& R, int& C) { const int st = b / 1024, sb = b % 1024, swz = sb ^ (((sb >> 9) & 1) << 5); R = (st >> 1) * 16 + swz / 64; C = (st & 1) * 32 + (swz % 64) / 2; }
__host__ __device__ __forceinline__ int perm32(int rho) { const int n = rho >> 4, i = rho & 15; return 8 * (i >> 2) + 4 * n + (i & 3); }

struct Unit { int pm, pn, kofs, nt, sp; };
struct Gemm { const bf16_t* A; const bf16_t* Bt; int M, N, K; };

struct StaticOrder {
    float rnig;
    int nM, nN, nwg, G, c, ntK, nsplit, nextra, mext;
    __host__ __device__ __forceinline__ void init(int M, int N, int G_, int c_) { nM = M / BM; nN = N / BM; nwg = nM * nN; G = G_; c = c_; ntK = 0; nsplit = 0; nextra = 0; mext = 0; rnig = 1.0f / (float)(WGM * nN); }
    __host__ __device__ __forceinline__ bool next(int i, Unit& u) const {
        const long L = (long)i * G + c;
        const bool ext = L >= nwg; const int L2 = (int)(L - nwg);
        if (ext && (nsplit == 0 || L2 >= nextra * nN * nsplit)) return false;
        int pm, pn, kofs = 0, ntu = ntK, sp = -1;
        if (ext) { pm = mext + L2 / (nN * nsplit); pn = (L2 / nsplit) % nN; sp = L2 % nsplit; ntu = ntK / nsplit; kofs = sp * ntu * BK; }
        else {
            int wgid = (int)L; { const int q = nwg / NXCD, r = nwg % NXCD, xcd = wgid % NXCD, off = wgid / NXCD; wgid = (xcd < r ? xcd * (q + 1) : r * (q + 1) + (xcd - r) * q) + off; }
            const int nig = WGM * nN, gid = (int)(((float)wgid + 0.5f) * rnig), fm = gid * WGM, rem = wgid - gid * nig;
            const int gsz = (nM - fm) < WGM ? (nM - fm) : WGM;
            if (gsz == WGM) { pm = fm + (rem & (WGM - 1)); pn = rem / WGM; }
            else { pm = fm + (rem % gsz); pn = rem / gsz; }
        }
        u.pm = pm; u.pn = pn; u.kofs = kofs; u.nt = ntu; u.sp = sp; return true;
    }
    __device__ __forceinline__ void a_ready(const Unit&) const {}
    __device__ __forceinline__ void done(const Unit&) const {}
};

__device__ __forceinline__ unsigned cvt_pk_bf16(float lo, float hi) { unsigned r; asm volatile("v_cvt_pk_bf16_f32 %0, %1, %2" : "=v"(r) : "v"(lo), "v"(hi)); return r; }
typedef float f32x2 __attribute__((ext_vector_type(2)));
template <class Epi, class Sched, bool ALIGN_EPI = false, bool SP2 = false>
__device__ __forceinline__ void gemm_phase(int wave_s, PG8_LAS unsigned char* lds, const Gemm g, const Sched& S, const Epi& E) {
    int tid_; asm volatile("v_mbcnt_lo_u32_b32 %0, -1, 0\n\tv_mbcnt_hi_u32_b32 %0, -1, %0" : "=v"(tid_)); tid_ += wave_s * 64;
    const int tid = tid_, wid = __builtin_amdgcn_readfirstlane(tid >> 6), lane = tid & 63, wr = wid >> 2, wc = wid & 3, fr = lane & 15, fq = lane >> 4;
    const int K = g.K;
    unsigned voffA[2], voffB[2];
#pragma unroll
    for (int i = 0; i < 2; ++i) { int R, C; stage_rc(tid * 16 + i * 8192, R, C); const int Rb = Epi::PERM ? ((R & ~31) + perm32(R & 31)) : R;
        voffA[i] = (unsigned)(R * K + C) * 2u; voffB[i] = (unsigned)(Rb * K + C) * 2u; }
    const size_t kstep = (size_t)(BK * 2);
    const size_t hstep = (size_t)HALF * K * 2;
    const size_t tstep = 2 * hstep;
    const unsigned ldsw = (unsigned)wid * 1024u;
    const int aoff = lds_byte(wr * 64 + fr, fq * 8), boff = lds_byte(wc * 32 + fr, fq * 8);
#define PG8_SA(b, h) (((b) * 2 + (h)) * HTB)
#define PG8_SB(b, h) ((4 + (b) * 2 + (h)) * HTB)
#define PG8_STAGE(bufoff, gbase, voff) do { _Pragma("unroll") for (int _i = 0; _i < 2; ++_i) \
        __builtin_amdgcn_global_load_lds((const unsigned*)((const char*)(gbase) + (voff)[_i]), (PG8_LAS unsigned*)(lds + (bufoff) + ldsw + _i * 8192), 16, 0, 0); } while (0)
#define PG8_LDA(dst, b, h) do { _Pragma("unroll") for (int m = 0; m < 4; ++m) _Pragma("unroll") for (int k = 0; k < 2; ++k) dst[m][k] = *(const PG8_LAS bf16x8*)(lds + PG8_SA(b, h) + aoff + m * 2048 + k * 1024); } while (0)
#define PG8_LDB(dst, b, h) do { _Pragma("unroll") for (int n = 0; n < 2; ++n) _Pragma("unroll") for (int k = 0; k < 2; ++k) dst[n][k] = *(const PG8_LAS bf16x8*)(lds + PG8_SB(b, h) + boff + n * 2048 + k * 1024); } while (0)
#define PG8_MMA(ai, bj, At, Bt) do { __builtin_amdgcn_s_setprio(1); _Pragma("unroll") for (int m = 0; m < 4; ++m) _Pragma("unroll") for (int n = 0; n < 2; ++n) _Pragma("unroll") for (int k = 0; k < 2; ++k) \
        acc[ai][bj][m][n] = __builtin_amdgcn_mfma_f32_16x16x32_bf16(Bt[n][k], At[m][k], acc[ai][bj][m][n], 0, 0, 0); __builtin_amdgcn_s_setprio(0); } while (0)
#define PG8_WAIT_V(n) asm volatile("s_waitcnt vmcnt(" #n ")" ::: "memory")
#define PG8_WAIT_L(n) asm volatile("s_waitcnt lgkmcnt(" #n ")" ::: "memory")
#define PG8_BAR __builtin_amdgcn_s_barrier()
#define PG8_SCHED __builtin_amdgcn_sched_barrier(0)
    Unit cur, nxt; int ui = 0;
    if (!S.next(0, cur)) return;
    f32x4 acc[2][2][4][2];
#pragma unroll
    for (int a = 0; a < 2; ++a)
#pragma unroll
        for (int b = 0; b < 2; ++b)
#pragma unroll
            for (int m = 0; m < 4; ++m)
#pragma unroll
                for (int n = 0; n < 2; ++n) acc[a][b][m][n] = (f32x4){0.f, 0.f, 0.f, 0.f};
    bf16x8 At[4][2], B0[2][2], B1[2][2];
    const char* cA = (const char*)g.A + (size_t)cur.pm * tstep + (size_t)cur.kofs * 2; const char* cB = (const char*)g.Bt + (size_t)cur.pn * tstep + (size_t)cur.kofs * 2;
    S.a_ready(cur);
    if constexpr (SP2) {
        PG8_STAGE(PG8_SB(0, 0), cB, voffB); PG8_STAGE(PG8_SB(0, 1), cB + hstep, voffB); PG8_STAGE(PG8_SA(0, 0), cA, voffA); PG8_STAGE(PG8_SA(0, 1), cA + hstep, voffA);
        if (wr == 1) PG8_BAR;
        PG8_WAIT_V(2); PG8_BAR;
        PG8_STAGE(PG8_SB(1, 0), cB + kstep, voffB); PG8_STAGE(PG8_SA(1, 0), cA + kstep, voffA); PG8_STAGE(PG8_SB(1, 1), cB + hstep + kstep, voffB);
        PG8_WAIT_V(6); PG8_BAR;
    } else {
        PG8_STAGE(PG8_SB(0, 0), cB, voffB); PG8_STAGE(PG8_SA(0, 0), cA, voffA); PG8_STAGE(PG8_SB(0, 1), cB + hstep, voffB); PG8_STAGE(PG8_SA(0, 1), cA + hstep, voffA);
        if (wr == 1) PG8_BAR;
        PG8_WAIT_V(4); PG8_BAR;
        PG8_STAGE(PG8_SB(1, 0), cB + kstep, voffB); PG8_STAGE(PG8_SA(1, 0), cA + kstep, voffA); PG8_STAGE(PG8_SB(1, 1), cB + hstep + kstep, voffB);
        PG8_WAIT_V(6); PG8_BAR;
    }
    for (;;) {
        const bool has_next = S.next(ui + 1, nxt);
        const char* nA = has_next ? (const char*)g.A + (size_t)nxt.pm * tstep + (size_t)nxt.kofs * 2 : cA; const char* nB = has_next ? (const char*)g.Bt + (size_t)nxt.pn * tstep + (size_t)nxt.kofs * 2 : cB;
        const int nt = cur.nt;
        for (int t = 0; t < nt; t += 2) {
            const bool last = (t == nt - 2);
            const char* a1 = cA + (size_t)(t + 1) * kstep;
            const char* a2 = last ? nA : cA + (size_t)(t + 2) * kstep; const char* b2 = last ? nB : cB + (size_t)(t + 2) * kstep;
            const char* a3 = a2 + kstep; const char* b3 = b2 + kstep;
            if (last && has_next) S.a_ready(nxt);
            if constexpr (SP2) {
            PG8_LDB(B0, 0, 0); PG8_LDB(B1, 0, 1); PG8_SCHED; PG8_LDA(At, 0, 0); PG8_STAGE(PG8_SA(1, 1), a1 + hstep, voffA);
            PG8_WAIT_V(8); PG8_WAIT_L(0); PG8_BAR; PG8_MMA(0, 0, At, B0); PG8_MMA(0, 1, At, B1); PG8_BAR; PG8_SCHED;
            PG8_LDA(At, 0, 1); PG8_STAGE(PG8_SB(0, 0), b2, voffB); PG8_STAGE(PG8_SB(0, 1), b2 + hstep, voffB); PG8_STAGE(PG8_SA(0, 0), a2, voffA);
            PG8_WAIT_V(8); PG8_WAIT_L(0); PG8_BAR; PG8_MMA(1, 0, At, B0); PG8_MMA(1, 1, At, B1); PG8_BAR; PG8_SCHED;
            PG8_LDB(B0, 1, 0); PG8_LDB(B1, 1, 1); PG8_SCHED; PG8_LDA(At, 1, 0); PG8_STAGE(PG8_SA(0, 1), a2 + hstep, voffA);
            PG8_WAIT_V(8); PG8_WAIT_L(0); PG8_BAR; PG8_MMA(0, 0, At, B0); PG8_MMA(0, 1, At, B1); PG8_BAR; PG8_SCHED;
            PG8_LDA(At, 1, 1); PG8_STAGE(PG8_SB(1, 0), b3, voffB); PG8_STAGE(PG8_SB(1, 1), b3 + hstep, voffB); PG8_STAGE(PG8_SA(1, 0), a3, voffA);
            PG8_WAIT_V(8); PG8_WAIT_L(0); PG8_BAR; PG8_MMA(1, 0, At, B0); PG8_MMA(1, 1, At, B1); PG8_BAR; PG8_SCHED;
            } else {
            PG8_LDB(B0, 0, 0); PG8_SCHED; PG8_LDA(At, 0, 0); PG8_STAGE(PG8_SA(1, 1), a1 + hstep, voffA);
            PG8_WAIT_L(8); PG8_BAR; PG8_WAIT_L(0); PG8_MMA(0, 0, At, B0); PG8_BAR; PG8_SCHED;
            PG8_LDB(B1, 0, 1); PG8_STAGE(PG8_SB(0, 0), b2, voffB);
            PG8_BAR; PG8_WAIT_L(0); PG8_MMA(0, 1, At, B1); PG8_BAR;
            PG8_LDA(At, 0, 1); PG8_STAGE(PG8_SA(0, 0), a2, voffA);
            PG8_BAR; PG8_WAIT_L(0); PG8_MMA(1, 0, At, B0); PG8_BAR; PG8_SCHED;
            PG8_STAGE(PG8_SB(0, 1), b2 + hstep, voffB);
            PG8_WAIT_V(6); PG8_BAR; PG8_MMA(1, 1, At, B1); PG8_BAR;
            PG8_LDB(B0, 1, 0); PG8_SCHED; PG8_LDA(At, 1, 0); PG8_STAGE(PG8_SA(0, 1), a2 + hstep, voffA);
            PG8_WAIT_L(8); PG8_BAR; PG8_WAIT_L(0); PG8_MMA(0, 0, At, B0); PG8_BAR; PG8_SCHED;
            PG8_LDB(B1, 1, 1); PG8_STAGE(PG8_SB(1, 0), b3, voffB);
            PG8_BAR; PG8_WAIT_L(0); PG8_MMA(0, 1, At, B1); PG8_BAR;
            PG8_LDA(At, 1, 1); PG8_STAGE(PG8_SA(1, 0), a3, voffA);
            PG8_BAR; PG8_WAIT_L(0); PG8_MMA(1, 0, At, B0); PG8_BAR; PG8_SCHED;
            PG8_STAGE(PG8_SB(1, 1), b3 + hstep, voffB);
            PG8_WAIT_V(6); PG8_BAR; PG8_MMA(1, 1, At, B1); PG8_BAR;
            }
        }
        if constexpr (ALIGN_EPI) { if (wr == 0) PG8_BAR; }
        if constexpr (!Epi::AFTER_DRAIN) { E(acc, cur, wr, wc, fr, fq); S.done(cur); }
        if (!has_next) break;
#pragma unroll
        for (int a = 0; a < 2; ++a)
#pragma unroll
            for (int b = 0; b < 2; ++b)
#pragma unroll
                for (int m = 0; m < 4; ++m)
#pragma unroll
                    for (int n = 0; n < 2; ++n) acc[a][b][m][n] = (f32x4){0.f, 0.f, 0.f, 0.f};
        cur = nxt; cA = nA; cB = nB; ++ui;
        if constexpr (ALIGN_EPI) { if (wr == 1) PG8_BAR; }
    }
    PG8_WAIT_V(0);
    if constexpr (!ALIGN_EPI) { if (wr == 0) PG8_BAR; }
    PG8_BAR;
    if constexpr (Epi::AFTER_DRAIN) { E.fused(acc, cur, wr, wc, fr, fq, lds, wid, lane); S.done(cur); }
#undef PG8_SA
#undef PG8_SB
#undef PG8_STAGE
#undef PG8_LDA
#undef PG8_LDB
#undef PG8_MMA
#undef PG8_WAIT_V
#undef PG8_WAIT_L
#undef PG8_BAR
#undef PG8_SCHED
}
}

constexpr int BATCH = 8, SEQ = 4096, DM = 1024, CTXL = 256, DEPTH = 4;
constexpr int RLAT = BATCH * SEQ, RCTX = BATCH * CTXL, RALL = RLAT + RCTX;
constexpr int KEYS = SEQ + CTXL;
constexpr int DFF = 4096, NMODC = 6 * DM;
constexpr float NORM_EPS = 1e-6f;
constexpr float QSCALE = 0.125f * 1.4426950408889634f;

constexpr size_t MiB = 1u << 20;
constexpr size_t WS_MOD = 0;
constexpr size_t WS_BAR = 960 * 1024;
constexpr size_t WS_ROPE = 1 * MiB;
constexpr size_t WS_W = 2 * MiB;
constexpr size_t WS_U = 18 * MiB;
constexpr size_t WS_Q = 86 * MiB;
constexpr size_t WS_K = 154 * MiB;
constexpr size_t WS_V = 222 * MiB;
constexpr size_t WS_O = 358 * MiB;
constexpr size_t WS_HC = 494 * MiB;
constexpr size_t WS_END = 502 * MiB;
constexpr size_t WS_HID = WS_K;
constexpr int LDS_BYTES = 147456;

#define LAS __attribute__((address_space(3)))
typedef unsigned short bf16_t;
typedef short bf16x8 __attribute__((ext_vector_type(8)));
typedef float f32x4 __attribute__((ext_vector_type(4)));
typedef float f32x16 __attribute__((ext_vector_type(16)));
typedef unsigned u32x4 __attribute__((ext_vector_type(4)));
typedef unsigned u32x2 __attribute__((ext_vector_type(2)));

__device__ __forceinline__ unsigned pk2(float lo, float hi) { typedef float f2_t __attribute__((ext_vector_type(2))); typedef __bf16 b2_t __attribute__((ext_vector_type(2))); f2_t v = {lo, hi}; b2_t b = __builtin_convertvector(v, b2_t); return __builtin_bit_cast(unsigned, b); }
__device__ __forceinline__ bf16_t f2bf(float f) { return (bf16_t)(pk2(f, 0.f) & 0xffffu); }
__device__ __forceinline__ float bflo(unsigned w) { return __uint_as_float(w << 16); }
__device__ __forceinline__ float bfhi(unsigned w) { return __uint_as_float(w & 0xffff0000u); }
__device__ __forceinline__ u32x4 pack8(f32x4 lo, f32x4 hi) { u32x4 w; w.x = pk2(lo[0], lo[1]); w.y = pk2(lo[2], lo[3]); w.z = pk2(hi[0], hi[1]); w.w = pk2(hi[2], hi[3]); return w; }
__device__ __forceinline__ u32x4 scale8(u32x4 w, float s) { u32x4 o; o.x = pk2(bflo(w.x) * s, bfhi(w.x) * s); o.y = pk2(bflo(w.y) * s, bfhi(w.y) * s); o.z = pk2(bflo(w.z) * s, bfhi(w.z) * s); o.w = pk2(bflo(w.w) * s, bfhi(w.w) * s); return o; }
__device__ __forceinline__ float xor32_sum(float v) { const auto r = __builtin_amdgcn_permlane32_swap(__float_as_uint(v), __float_as_uint(v), false, false); return __uint_as_float(r[0]) + __uint_as_float(r[1]); }
__device__ __forceinline__ float xor32_max(float v) { const auto r = __builtin_amdgcn_permlane32_swap(__float_as_uint(v), __float_as_uint(v), false, false); return __builtin_fmaxf(__uint_as_float(r[0]), __uint_as_float(r[1])); }
__device__ __forceinline__ float xor16_sum(float v) { const auto r = __builtin_amdgcn_permlane16_swap(__float_as_uint(v), __float_as_uint(v), false, false); return __uint_as_float(r[0]) + __uint_as_float(r[1]); }
template <int CTRL> __device__ __forceinline__ float dpp_sum(float v) { return v + __uint_as_float(__builtin_amdgcn_update_dpp(0u, __float_as_uint(v), CTRL, 0xf, 0xf, true)); }
__device__ __forceinline__ float wave_sum(float v) {
    v = dpp_sum<0xB1>(v);
    v = dpp_sum<0x4E>(v);
    v = dpp_sum<0x141>(v);
    v = dpp_sum<0x140>(v);
    v = xor16_sum(v);
    return xor32_sum(v);
}
__device__ __forceinline__ float silu_f(float x) { return x * __builtin_amdgcn_rcpf(1.0f + __expf(-x)); }
__device__ __forceinline__ f32x16 mfma32(bf16x8 a, bf16x8 b, f32x16 c) { return __builtin_amdgcn_mfma_f32_32x32x16_bf16(a, b, c, 0, 0, 0); }
__device__ __forceinline__ int kappa(int m) { return (m & ~12) | ((m & 4) << 1) | ((m & 8) >> 1); }
__device__ __forceinline__ void rope8(f32x4& lo, f32x4& hi, const f32x4 c, const f32x4 s) {
    float a, b;
    a = lo[0]; b = lo[1]; lo[0] = a * c[0] - b * s[0]; lo[1] = a * s[0] + b * c[0];
    a = lo[2]; b = lo[3]; lo[2] = a * c[1] - b * s[1]; lo[3] = a * s[1] + b * c[1];
    a = hi[0]; b = hi[1]; hi[0] = a * c[2] - b * s[2]; hi[1] = a * s[2] + b * c[2];
    a = hi[2]; b = hi[3]; hi[2] = a * c[3] - b * s[3]; hi[3] = a * s[3] + b * c[3];
}

struct Ids { int tid, lane, wave, vcu, G; };
__device__ __forceinline__ int hw_lane() { int l; asm volatile("v_mbcnt_lo_u32_b32 %0, -1, 0\n\tv_mbcnt_hi_u32_b32 %0, -1, %0" : "=v"(l)); return l; }
__device__ __forceinline__ int hw_tid(int wave_s) { return wave_s * 64 + hw_lane(); }
__device__ __forceinline__ Ids make_ids(int wave_s) {
    Ids I; int t = hw_tid(wave_s); asm volatile("" : "+v"(t));
    I.tid = t; I.lane = t & 63; I.wave = __builtin_amdgcn_readfirstlane(t >> 6); I.G = gridDim.x;
    const int bx = blockIdx.x; I.vcu = (I.G % 8 == 0) ? (bx % 8) * (I.G / 8) + bx / 8 : bx;
    return I;
}

struct EpiP {
    bf16_t* o0; bf16_t* o1; bf16_t* o2;
    const float* rc; const float* rs;
    const float* hin_l; const float* hin_c; float* hout_l; float* hout_c; const float* gate;
    float* part;
};
template <int MODE> struct Epi {
    static constexpr bool PERM = true, AFTER_DRAIN = false;
    EpiP p;
    __device__ __forceinline__ void operator()(const pg8::f32x4 (&acc)[2][2][4][2], const pg8::Unit& u, int wr, int wc, int fr, int fq) const {
        const int upm = u.pm, upn = u.pn, usp = u.sp;
#pragma unroll
        for (int ai = 0; ai < 2; ++ai)
#pragma unroll
            for (int m = 0; m < 4; ++m) {
                int fr_ = fr; asm volatile("" : "+v"(fr_) :: "memory");
                const int row = upm * 256 + ai * 128 + wr * 64 + m * 16 + fr_;
                const bool lat = row < RLAT;
                int b, pos;
                if (lat) { b = row >> 12; pos = row & (SEQ - 1); } else { const int r2 = row - RLAT; b = r2 >> 8; pos = SEQ + (r2 & (CTXL - 1)); }
#pragma unroll
                for (int bj = 0; bj < 2; ++bj) {
                    const int c = upn * 256 + bj * 128 + wc * 32 + 8 * fq;
                    f32x4 lo = acc[ai][bj][m][0], hi = acc[ai][bj][m][1];
                    if constexpr (MODE == 0) {
                        const int sec = c >> 10;
                        if (sec < 2) {
                            const int cc = c & 1023, head = cc >> 7, i = (cc >> 6) & 1, pp = cc & 63;
                            if (lat) { const int pidx = (pp < 32) ? (pos >> 6) : (pos & 63); const int j0 = (pp & 31) >> 1;
                                const f32x4 cs = *(const f32x4*)(p.rc + pidx * 16 + j0), sn = *(const f32x4*)(p.rs + pidx * 16 + j0); rope8(lo, hi, cs, sn); }
                            if (sec == 0) { lo = lo * QSCALE; hi = hi * QSCALE; }
                            bf16_t* dst = (sec == 0 ? p.o0 : p.o1) + ((size_t)((b * 8 + head) * 2 + i) * KEYS + pos) * 64 + pp;
                            *(u32x4*)dst = pack8(lo, hi);
                        } else {
                            const int cc = c - 2048, head = cc >> 7, dv = cc & 127;
                            bf16_t* dst = p.o2 + ((size_t)((b * 8 + head) * 128 + dv)) * KEYS + pos;
                            dst[0] = f2bf(lo[0]); dst[KEYS] = f2bf(lo[1]); dst[2 * KEYS] = f2bf(lo[2]); dst[3 * KEYS] = f2bf(lo[3]);
                            dst[4 * KEYS] = f2bf(hi[0]); dst[5 * KEYS] = f2bf(hi[1]); dst[6 * KEYS] = f2bf(hi[2]); dst[7 * KEYS] = f2bf(hi[3]);
                        }
                    } else if constexpr (MODE == 1) {
                        if (c < 2048) {
                            const int sec = c >> 10, cc = c & 1023, pp = cc & 255;
                            if (lat && p.rc) {
                                const float pf = (float)((pp < 128) ? (pos >> 6) : (pos & 63)); const int j0 = (pp & 127) >> 1;
                                const f32x4 rv = *(const f32x4*)(p.rc + j0) * pf; f32x4 cs, sn;
#pragma unroll
                                for (int t = 0; t < 4; ++t) { cs[t] = __builtin_amdgcn_cosf(rv[t]); sn[t] = __builtin_amdgcn_sinf(rv[t]); }
                                rope8(lo, hi, cs, sn); }
                            if (sec == 1) { lo = lo * 0.0625f; hi = hi * 0.0625f; }
                            bf16_t* dst = (sec == 0 ? p.o0 : p.o1) + (size_t)row * 1024 + cc;
                            *(u32x4*)dst = pack8(lo, hi);
                        } else {
                            bf16_t* dst = p.o2 + (size_t)row * 2048 + (c - 2048);
                            *(u32x4*)dst = pack8(lo, hi);
                        }
                    } else if constexpr (MODE == 2) {
                        if (usp >= 0) {
                            float* pp = p.part + ((size_t)usp * RCTX + (size_t)(row - RLAT)) * DM + c;
                            *(f32x4*)pp = lo; *(f32x4*)(pp + 4) = hi;
                        } else {
                        const float* hin; float* hout; int bidx;
                        if (lat) { hin = p.hin_l + (size_t)row * DM; hout = p.hout_l + (size_t)row * DM; bidx = b; }
                        else { const size_t r2 = (size_t)(row - RLAT); hin = p.hin_c + r2 * DM; hout = p.hout_c + r2 * DM; bidx = 8; }
                        const float* g = p.gate + bidx * NMODC + c;
                        const f32x4 g0 = *(const f32x4*)g, g1 = *(const f32x4*)(g + 4), h0 = *(const f32x4*)(hin + c), h1 = *(const f32x4*)(hin + c + 4);
                        *(f32x4*)(hout + c) = h0 + g0 * lo; *(f32x4*)(hout + c + 4) = h1 + g1 * hi;
                        }
                    } else if constexpr (MODE == 3) {
#pragma unroll
                        for (int j = 0; j < 4; ++j) { const float a = fmaxf(lo[j], 0.f), d = fmaxf(hi[j], 0.f); lo[j] = a * a; hi[j] = d * d; }
                        *(u32x4*)(p.o0 + (size_t)row * DFF + c) = pack8(lo, hi);
                    } else {
                        bf16_t* dst = p.o0 + (size_t)row * 2048 + c;
                        const u32x4 w = *(const u32x4*)dst;
                        lo[0] = silu_f(lo[0]) * bflo(w.x); lo[1] = silu_f(lo[1]) * bfhi(w.x); lo[2] = silu_f(lo[2]) * bflo(w.y); lo[3] = silu_f(lo[3]) * bfhi(w.y);
                        hi[0] = silu_f(hi[0]) * bflo(w.z); hi[1] = silu_f(hi[1]) * bfhi(w.z); hi[2] = silu_f(hi[2]) * bflo(w.w); hi[3] = silu_f(hi[3]) * bfhi(w.w);
                        *(u32x4*)dst = pack8(lo, hi);
                    }
                }
                asm volatile("" ::: "memory");
            }
    }
};

template <int MODE> __device__ __forceinline__ void run_gemm(int wave_s, LAS unsigned char* lds, const bf16_t* A, const bf16_t* Bt, int M, int N, int K, const EpiP& ep, bool split_ctx = false) {
    pg8::Gemm g{A, Bt, M, N, K}; pg8::StaticOrder S; S.init(split_ctx ? RLAT : M, N, (int)gridDim.x, (int)blockIdx.x); S.ntK = K / 64;
    if (split_ctx) { S.nsplit = 4; S.nextra = RCTX / 256; S.mext = RLAT / 256; }
    Epi<MODE> E{ep};
    pg8::gemm_phase<Epi<MODE>, pg8::StaticOrder, true, true>(wave_s, lds, g, S, E);
}

__device__ __forceinline__ int srccol(int mode, int n) {
    if (mode == 1 && n < 2048) { const int base = n & ~63, p = n & 63, half = p >> 5, q = p & 31, j = q >> 1; return base + half * 32 + ((q & 1) ? j + 16 : j); }
    if (mode == 2 && n < 2048) { const int base = n & ~255, p = n & 255, half = p >> 7, q = p & 127, j = q >> 1; return base + half * 128 + ((q & 1) ? j + 64 : j); }
    return n;
}
__device__ __forceinline__ void conv_item(const float* W, int K, int N, bf16_t* WT, int mode, LAS float* scr, int item, int lane) {
    const int nblk = N / 32, kb = item / nblk, nb = item % nblk, k0 = 64 * kb, n0 = 32 * nb;
    const int sc = srccol(mode, n0 + (lane & 31));
#pragma unroll 8
    for (int i = 0; i < 32; ++i) { const int kk = 2 * i + (lane >> 5); scr[kk * 33 + (lane & 31)] = W[(size_t)(k0 + kk) * N + sc]; }
    asm volatile("s_waitcnt lgkmcnt(0)" ::: "memory");
    const int c = lane & 7;
#pragma unroll
    for (int j = 0; j < 4; ++j) { const int n = (lane >> 3) + 8 * j; const LAS float* s = scr + (8 * c) * 33 + n;
        u32x4 o; o.x = pk2(s[0 * 33], s[1 * 33]); o.y = pk2(s[2 * 33], s[3 * 33]); o.z = pk2(s[4 * 33], s[5 * 33]); o.w = pk2(s[6 * 33], s[7 * 33]);
        *(u32x4*)(WT + (size_t)(n0 + n) * K + k0 + 8 * c) = o; }
    asm volatile("s_waitcnt lgkmcnt(0)" ::: "memory");
}
__device__ __forceinline__ void conv_two(int wave_s, LAS unsigned char* lds, const float* W0, int K0, int N0, bf16_t* T0, int mode0, const float* W1, int K1, int N1, bf16_t* T1, int first_block = 0) {
    const Ids I = make_ids(wave_s);
    LAS float* scr = (LAS float*)(lds + I.wave * 16384);
    if ((int)blockIdx.x < first_block) return;
    const int gw = (first_block ? (int)blockIdx.x - first_block : I.vcu) * 8 + I.wave, NGW = (I.G - first_block) * 8;
    const int n0 = (K0 / 64) * (N0 / 32), n1 = (K1 / 64) * (N1 / 32);
    for (int it = gw; it < n0 + n1; it += NGW) {
        if (it < n0) conv_item(W0, K0, N0, T0, mode0, scr, it, I.lane);
        else conv_item(W1, K1, N1, T1, 0, scr, it - n0, I.lane);
    }
}

__device__ __forceinline__ void norm_rows(int wave_s, const float* hl, const float* hc, const float* modL, int shoff, int scoff, bf16_t* U, int nrows, const float* part = nullptr, const float* gate_c = nullptr, float* hc_out = nullptr) {
    const Ids I = make_ids(wave_s);
    const int gw = I.vcu * 8 + I.wave, NGW = I.G * 8;
    for (int grp = gw; grp < RLAT / 4; grp += NGW) {
        const int row0 = grp * 4, bidx = row0 >> 12;
        const float* src = hl + (size_t)row0 * DM + 4 * I.lane;
        const float* sh = modL + bidx * NMODC + shoff + 4 * I.lane; const float* sc = modL + bidx * NMODC + scoff + 4 * I.lane;
        f32x4 v[4][4];
#pragma unroll
        for (int r = 0; r < 4; ++r)
#pragma unroll
            for (int j = 0; j < 4; ++j) v[r][j] = *(const f32x4*)(src + r * DM + 256 * j);
        float rstd[4];
#pragma unroll
        for (int r = 0; r < 4; ++r) { float s = 0.f;
#pragma unroll
            for (int j = 0; j < 4; ++j) s += (v[r][j][0] * v[r][j][0] + v[r][j][1] * v[r][j][1]) + (v[r][j][2] * v[r][j][2] + v[r][j][3] * v[r][j][3]);
            rstd[r] = rsqrtf(wave_sum(s) * (1.0f / DM) + NORM_EPS); }
#pragma unroll
        for (int j = 0; j < 4; ++j) { const f32x4 a = *(const f32x4*)(sc + 256 * j) + 1.0f, bs = *(const f32x4*)(sh + 256 * j);
#pragma unroll
            for (int r = 0; r < 4; ++r) { const f32x4 o = v[r][j] * rstd[r] * a + bs; u32x2 w; w.x = pk2(o[0], o[1]); w.y = pk2(o[2], o[3]); *(u32x2*)(U + (size_t)(row0 + r) * DM + 4 * I.lane + 256 * j) = w; } }
    }
    for (int row = RLAT + gw; row < nrows; row += NGW) {
        const float* src = hc + (size_t)(row - RLAT) * DM;
        const float* sh = modL + 8 * NMODC + shoff; const float* sc = modL + 8 * NMODC + scoff;
        f32x4 v[4]; float s = 0.f;
#pragma unroll
        for (int j = 0; j < 4; ++j) { const int c = 4 * I.lane + 256 * j; v[j] = *(const f32x4*)(src + c);
            if (part) { const float* pp = part + (size_t)(row - RLAT) * DM + c; const size_t ps = (size_t)RCTX * DM;
                const f32x4 ps4 = (*(const f32x4*)pp + *(const f32x4*)(pp + ps)) + (*(const f32x4*)(pp + 2 * ps) + *(const f32x4*)(pp + 3 * ps));
                v[j] = v[j] + *(const f32x4*)(gate_c + c) * ps4; *(f32x4*)(hc_out + (size_t)(row - RLAT) * DM + c) = v[j]; }
            s += (v[j][0] * v[j][0] + v[j][1] * v[j][1]) + (v[j][2] * v[j][2] + v[j][3] * v[j][3]); }
        const float rstd = rsqrtf(wave_sum(s) * (1.0f / DM) + NORM_EPS);
#pragma unroll
        for (int j = 0; j < 4; ++j) { const int c = 4 * I.lane + 256 * j; const f32x4 a = *(const f32x4*)(sc + c), bs = *(const f32x4*)(sh + c);
            const f32x4 o = v[j] * rstd * (a + 1.0f) + bs; u32x2 w; w.x = pk2(o[0], o[1]); w.y = pk2(o[2], o[3]); *(u32x2*)(U + (size_t)row * DM + c) = w; }
    }
}
__device__ __forceinline__ void final_norm(int wave_s, float* h, const float* g) {
    const Ids I = make_ids(wave_s);
    const int gw = I.vcu * 8 + I.wave, NGW = I.G * 8;
    for (int grp = gw; grp < RLAT / 4; grp += NGW) {
        float* src = h + (size_t)grp * 4 * DM + 4 * I.lane;
        f32x4 v[4][4];
#pragma unroll
        for (int r = 0; r < 4; ++r)
#pragma unroll
            for (int j = 0; j < 4; ++j) v[r][j] = *(const f32x4*)(src + r * DM + 256 * j);
        float rstd[4];
#pragma unroll
        for (int r = 0; r < 4; ++r) { float s = 0.f;
#pragma unroll
            for (int j = 0; j < 4; ++j) s += (v[r][j][0] * v[r][j][0] + v[r][j][1] * v[r][j][1]) + (v[r][j][2] * v[r][j][2] + v[r][j][3] * v[r][j][3]);
            rstd[r] = rsqrtf(wave_sum(s) * (1.0f / DM) + NORM_EPS); }
#pragma unroll
        for (int j = 0; j < 4; ++j) { const f32x4 a = *(const f32x4*)(g + 4 * I.lane + 256 * j);
#pragma unroll
            for (int r = 0; r < 4; ++r) *(f32x4*)(src + r * DM + 256 * j) = v[r][j] * rstd[r] * a; }
    }
}
__device__ __forceinline__ void gn_rows(int wave_s, bf16_t* O, int nrows) {
    const Ids I = make_ids(wave_s);
    const int gw = I.vcu * 8 + I.wave, NGW = I.G * 8;
    for (int grp = gw; grp < nrows / 4; grp += NGW) {
        bf16_t* p0 = O + (size_t)grp * 4 * 2048 + I.lane * 8;
        u32x4 w[4][4];
#pragma unroll
        for (int r = 0; r < 4; ++r)
#pragma unroll
            for (int hd = 0; hd < 4; ++hd) w[r][hd] = *(const u32x4*)(p0 + r * 2048 + hd * 512);
#pragma unroll
        for (int r = 0; r < 4; ++r)
#pragma unroll
            for (int hd = 0; hd < 4; ++hd) {
                const u32x4 ww = w[r][hd];
                float x0 = bflo(ww.x), x1 = bfhi(ww.x), x2 = bflo(ww.y), x3 = bfhi(ww.y), x4 = bflo(ww.z), x5 = bfhi(ww.z), x6 = bflo(ww.w), x7 = bfhi(ww.w);
                const float mean = wave_sum(((x0 + x1) + (x2 + x3)) + ((x4 + x5) + (x6 + x7))) * (1.0f / 512.0f);
                x0 -= mean; x1 -= mean; x2 -= mean; x3 -= mean; x4 -= mean; x5 -= mean; x6 -= mean; x7 -= mean;
                const float var = wave_sum(((x0 * x0 + x1 * x1) + (x2 * x2 + x3 * x3)) + ((x4 * x4 + x5 * x5) + (x6 * x6 + x7 * x7))) * (1.0f / 512.0f);
                const float rstd = rsqrtf(var + 1e-5f);
                u32x4 o; o.x = pk2(x0 * rstd, x1 * rstd); o.y = pk2(x2 * rstd, x3 * rstd); o.z = pk2(x4 * rstd, x5 * rstd); o.w = pk2(x6 * rstd, x7 * rstd);
                *(u32x4*)(p0 + r * 2048 + hd * 512) = o;
            }
    }
}

__device__ __forceinline__ void ada_phase(int wave_s, LAS unsigned char* lds, const float* c, const float* cctx, const float* ada_w, const float* ada_b, float* MOD) {
    const Ids I = make_ids(wave_s);
    LAS float* sl = (LAS float*)lds;
    LAS float* red = sl + 9 * 1024;
    for (int idx = I.tid; idx < 9 * 1024; idx += 512) { const int r = idx >> 10, k = idx & 1023; const float x = r < 8 ? c[r * 1024 + k] : cctx[k]; sl[idx] = silu_f(x); }
    __syncthreads();
    const int cgx = I.tid & 7, ks = I.tid >> 3;
    for (int item = blockIdx.x; item < 4 * 192; item += gridDim.x) {
        const int l = item / 192, n0 = (item % 192) * 32;
        f32x4 a0 = {0.f, 0.f, 0.f, 0.f}, a1 = a0, a2 = a0, a3 = a0, a4 = a0, a5 = a0, a6 = a0, a7 = a0, a8 = a0;
        const float* wp = ada_w + ((size_t)l * 1024 + ks * 16) * NMODC + n0 + 4 * cgx;
        const LAS float* sp = sl + ks * 16;
#pragma unroll 8
        for (int kk = 0; kk < 16; ++kk) {
            const f32x4 w = *(const f32x4*)(wp + (size_t)kk * NMODC);
            a0 += w * sp[kk]; a1 += w * sp[1024 + kk]; a2 += w * sp[2048 + kk]; a3 += w * sp[3072 + kk]; a4 += w * sp[4096 + kk];
            a5 += w * sp[5120 + kk]; a6 += w * sp[6144 + kk]; a7 += w * sp[7168 + kk]; a8 += w * sp[8192 + kk];
        }
        LAS f32x4* rp = (LAS f32x4*)(red + (ks * 8 + cgx) * 36);
        rp[0] = a0; rp[1] = a1; rp[2] = a2; rp[3] = a3; rp[4] = a4; rp[5] = a5; rp[6] = a6; rp[7] = a7; rp[8] = a8;
        __syncthreads();
        for (int o = I.tid; o < 288; o += 512) {
            const int r = o >> 5, col = o & 31, cg2 = col >> 2, j = col & 3; float s = 0.f;
            for (int k2 = 0; k2 < 64; ++k2) s += red[(k2 * 8 + cg2) * 36 + r * 4 + j];
            MOD[(size_t)(l * 9 + r) * NMODC + n0 + col] = s + ada_b[l * NMODC + n0 + col];
        }
        __syncthreads();
    }
}
__device__ __forceinline__ void rope_tables(float* T) {
    const int g = blockIdx.x * 512 + threadIdx.x;
    if (g < 64) T[10240 + g] = exp2f(-(float)g * (1.0f / 64.0f) * 13.287712379549449f) * 0.15915494309189535f;
    if (g < 1024 + 4096) {
        int pos, j; float e; float* cp; float* sp;
        if (g < 1024) { pos = g >> 4; j = g & 15; e = (float)j * (1.0f / 16.0f); cp = T + g; sp = T + 1024 + g; }
        else { const int g2 = g - 1024; pos = g2 >> 6; j = g2 & 63; e = (float)j * (1.0f / 64.0f); cp = T + 2048 + g2; sp = T + 2048 + 4096 + g2; }
        const float inv = exp2f(-e * 13.287712379549449f);
        const float ang = (float)pos * inv;
        const float n = rintf(ang * 0.15915494309189535f);
        float r = fmaf(-n, 6.2831854820251465f, ang); r = fmaf(-n, -1.7484555e-07f, r);
        *cp = __builtin_amdgcn_cosf(r * 0.15915494309189535f); *sp = __builtin_amdgcn_sinf(r * 0.15915494309189535f);
    }
}

__device__ __forceinline__ void attn_phase(int wave_s, LAS unsigned char* lds, const bf16_t* QA, const bf16_t* KA, const bf16_t* VT, bf16_t* OA, const float* lam, const float* subg, float lambda_init, bool need_ctx) {
    const Ids I = make_ids(wave_s);
    const int tid = I.tid, lane = I.lane, wave = I.wave, r32 = lane & 31, hi = lane >> 5, map = wave >> 2, wq = wave & 3;
    float s01 = 0.f, s23 = 0.f;
    for (int d = 0; d < 64; ++d) { s01 += lam[d] * lam[64 + d]; s23 += lam[128 + d] * lam[192 + d]; }
    const float lam_full = __expf(s01) - __expf(s23) + lambda_init;
    const float osc = 1.0f - lambda_init;
    const int nunits = 2048 + (need_ctx ? 128 : 0);
    constexpr int STG = 36864;
    const int krow = tid >> 3, kch = tid & 7;
    const int kro = kappa(r32) * 144 + hi * 16;
    for (int u = I.vcu; u < nunits; u += I.G) {
        int bh, q0, key0, nt, tok0;
        if (u < 2048) { bh = u >> 5; const int qb = u & 31; q0 = qb * 128; key0 = 0; nt = KEYS / 64; tok0 = (bh >> 3) * SEQ + q0; }
        else { const int v = u - 2048; bh = v >> 1; const int qb = v & 1; q0 = SEQ + qb * 128; key0 = SEQ; nt = CTXL / 64; tok0 = RLAT + (bh >> 3) * CTXL + qb * 128; }
        const int h = bh & 7;
        const bf16_t* qp = QA + ((size_t)(bh * 2 + map) * KEYS + q0 + wq * 32 + r32) * 64 + hi * 8;
        bf16x8 qf[4];
#pragma unroll
        for (int ks = 0; ks < 4; ++ks) qf[ks] = *(const bf16x8*)(qp + ks * 16);
        const bf16_t* k0p = KA + ((size_t)(bh * 2 + 0) * KEYS + key0 + krow) * 64 + kch * 8;
        const bf16_t* k1p = KA + ((size_t)(bh * 2 + 1) * KEYS + key0 + krow) * 64 + kch * 8;
        const bf16_t* v0p = VT + ((size_t)bh * 128 + krow) * KEYS + key0 + kch * 8;
        const bf16_t* v1p = v0p + (size_t)64 * KEYS;
        const int rot = (u < 2048) ? ((u & 31) * 2) : ((u & 1) * 2);
        u32x4 sk0 = *(const u32x4*)(k0p + (size_t)rot * 4096), sk1 = *(const u32x4*)(k1p + (size_t)rot * 4096), sv0 = *(const u32x4*)(v0p + rot * 64), sv1 = *(const u32x4*)(v1p + rot * 64);
#define ATT_WRITE(stoff) do { LAS unsigned char* sb_ = lds + (stoff) + krow * 144 + kch * 16; *(LAS u32x4*)(sb_) = sk0; *(LAS u32x4*)(sb_ + 9216) = sk1; *(LAS u32x4*)(sb_ + 18432) = sv0; *(LAS u32x4*)(sb_ + 18432 + 9216) = sv1; } while (0)
#define ATT_LOAD(tt) do { sk0 = *(const u32x4*)(k0p + (size_t)(tt) * 4096); sk1 = *(const u32x4*)(k1p + (size_t)(tt) * 4096); sv0 = *(const u32x4*)(v0p + (tt) * 64); sv1 = *(const u32x4*)(v1p + (tt) * 64); } while (0)
#define ATT_QK(P0, P1, stoff) do { const LAS unsigned char* kb_ = lds + (stoff) + map * 9216 + kro; \
            _Pragma("unroll") for (int r = 0; r < 16; ++r) { P0[r] = 0.f; P1[r] = 0.f; } \
            _Pragma("unroll") for (int ks = 0; ks < 4; ++ks) { const bf16x8 a0 = *(const LAS bf16x8*)(kb_ + ks * 32), a1 = *(const LAS bf16x8*)(kb_ + 32 * 144 + ks * 32); \
                P0 = mfma32(a0, qf[ks], P0); P1 = mfma32(a1, qf[ks], P1); } } while (0)
        f32x16 O[4];
        typedef float f32x8 __attribute__((ext_vector_type(8)));
        f32x8 lv8;
        volatile LAS unsigned* aflag = (volatile LAS unsigned*)(lds + LDS_BYTES - 64);
#define ATT_TILES(FAST) \
        for (int t = 0; t < nt; ++t) { \
            const int s0 = (t & 1) * STG, s1 = STG - s0; \
            ATT_WRITE(s1); \
            { int tl = t + 2 < nt ? t + 2 : nt - 1; tl += rot; tl = tl < nt ? tl : tl - nt; ATT_LOAD(tl); } \
            f32x16 pc0, pc1; \
            ATT_QK(pc0, pc1, s0); \
            if (!(FAST) && t == 0) { float m0 = __builtin_fmaxf(pc0[0], pc1[0]); \
                _Pragma("unroll") for (int r = 1; r < 16; ++r) m0 = __builtin_fmaxf(m0, __builtin_fmaxf(pc0[r], pc1[r])); \
                mref = xor32_max(m0); } \
            const LAS unsigned char* vb = lds + s0 + 18432 + r32 * 144 + hi * 16; \
            bf16x8 vf0 = *(const LAS bf16x8*)(vb), vf1 = *(const LAS bf16x8*)(vb + 32 * 144), vf2 = *(const LAS bf16x8*)(vb + 64 * 144), vf3 = *(const LAS bf16x8*)(vb + 96 * 144); \
            if (!(FAST)) { \
                pc0 = pc0 - mref; pc1 = pc1 - mref; \
                float mx = __builtin_fmaxf(__builtin_fmaxf(pc0[0], pc1[0]), pc0[1]); \
                mx = __builtin_fmaxf(__builtin_fmaxf(mx, pc1[1]), pc0[2]); \
                _Pragma("unroll") for (int r = 2; r < 15; ++r) mx = __builtin_fmaxf(__builtin_fmaxf(mx, pc1[r]), pc0[r + 1]); \
                mx = __builtin_fmaxf(mx, pc1[15]); \
                mx = xor32_max(mx); \
                if (__any(mx > 8.0f)) { \
                    const float dl = __builtin_fmaxf(mx, 0.f); mref += dl; pc0 = pc0 - dl; pc1 = pc1 - dl; \
                    const float alpha = __builtin_amdgcn_exp2f(-dl); lv8 = lv8 * alpha; \
                    _Pragma("unroll") for (int d = 0; d < 4; ++d) O[d] = O[d] * alpha; \
                } \
            } \
            _Pragma("unroll") for (int s = 0; s < 4; ++s) { \
                bf16x8 vn0 = vf0, vn1 = vf1, vn2 = vf2, vn3 = vf3; \
                if (s < 3) { vn0 = *(const LAS bf16x8*)(vb + (s + 1) * 32); vn1 = *(const LAS bf16x8*)(vb + 32 * 144 + (s + 1) * 32); vn2 = *(const LAS bf16x8*)(vb + 64 * 144 + (s + 1) * 32); vn3 = *(const LAS bf16x8*)(vb + 96 * 144 + (s + 1) * 32); } \
                f32x8 e; \
                _Pragma("unroll") for (int j = 0; j < 8; ++j) e[j] = __builtin_amdgcn_exp2f(s < 2 ? pc0[8 * s + j] : pc1[8 * (s - 2) + j]); \
                lv8 = lv8 + e; \
                u32x4 w; w.x = pk2(e[0], e[1]); w.y = pk2(e[2], e[3]); w.z = pk2(e[4], e[5]); w.w = pk2(e[6], e[7]); \
                const bf16x8 pb = __builtin_bit_cast(bf16x8, w); \
                O[0] = mfma32(vf0, pb, O[0]); O[1] = mfma32(vf1, pb, O[1]); O[2] = mfma32(vf2, pb, O[2]); O[3] = mfma32(vf3, pb, O[3]); \
                vf0 = vn0; vf1 = vn1; vf2 = vn2; vf3 = vn3; \
            } \
            __syncthreads(); \
        }
        float lsum = 0.f;
        for (int pass = 0; pass < 2; ++pass) {
            if (pass == 1) ATT_LOAD(rot);
            ATT_WRITE(0);
            ATT_LOAD(rot + 1 < nt ? rot + 1 : rot + 1 - nt);
            __syncthreads();
#pragma unroll
            for (int d = 0; d < 4; ++d)
#pragma unroll
                for (int r = 0; r < 16; ++r) O[d][r] = 0.f;
#pragma unroll
            for (int r = 0; r < 8; ++r) lv8[r] = 0.f;
            float mref = 0.f;
            if (pass == 0) { ATT_TILES(true) } else { ATT_TILES(false) }
            lsum = xor32_sum(((lv8[0] + lv8[1]) + (lv8[2] + lv8[3])) + ((lv8[4] + lv8[5]) + (lv8[6] + lv8[7])));
            if (pass == 1) break;
            const bool bad = !(lsum > 1e-30f && lsum < 1e30f);
            const unsigned wbad = __any(bad) ? 1u : 0u;
            if (lane == 0) aflag[wave] = wbad;
            __syncthreads();
            const unsigned any8 = aflag[0] | aflag[1] | aflag[2] | aflag[3] | aflag[4] | aflag[5] | aflag[6] | aflag[7];
            __syncthreads();
            if (any8 == 0u) break;
        }
#undef ATT_TILES
#undef ATT_WRITE
#undef ATT_LOAD
#undef ATT_QK
        const float inv = 1.0f / lsum;
        LAS float* X = (LAS float*)lds;
        const int xr = wq * 32 + r32;
        if (map == 1) {
#pragma unroll
            for (int d = 0; d < 4; ++d)
#pragma unroll
                for (int g = 0; g < 4; ++g) { f32x4 v = {O[d][4 * g] * inv, O[d][4 * g + 1] * inv, O[d][4 * g + 2] * inv, O[d][4 * g + 3] * inv}; *(LAS f32x4*)(X + xr * 132 + 32 * d + 8 * g + 4 * hi) = v; }
        }
        __syncthreads();
        if (map == 0) {
            float ss = 0.f;
#pragma unroll
            for (int d = 0; d < 4; ++d)
#pragma unroll
                for (int g = 0; g < 4; ++g) { const f32x4 o1 = *(const LAS f32x4*)(X + xr * 132 + 32 * d + 8 * g + 4 * hi);
#pragma unroll
                    for (int j = 0; j < 4; ++j) { const float df = O[d][4 * g + j] * inv - lam_full * o1[j]; O[d][4 * g + j] = df; ss += df * df; } }
            ss = xor32_sum(ss);
            const float rn = rsqrtf(ss * (1.0f / 128.0f) + NORM_EPS) * osc;
            bf16_t* op = OA + (size_t)(tok0 + xr) * DM + h * 128 + 4 * hi;
#pragma unroll
            for (int d = 0; d < 4; ++d)
#pragma unroll
                for (int g = 0; g < 4; ++g) { const int cdv = 32 * d + 8 * g; const f32x4 gg = *(const f32x4*)(subg + cdv + 4 * hi);
                    u32x2 w; w.x = pk2(O[d][4 * g] * rn * gg[0], O[d][4 * g + 1] * rn * gg[1]); w.y = pk2(O[d][4 * g + 2] * rn * gg[2], O[d][4 * g + 3] * rn * gg[3]);
                    *(u32x2*)(op + cdv) = w; }
        }
        __syncthreads();
    }
}

constexpr int SC_QD = 0, SC_KD = 18432, SC_BUF = 36864, SC_SQ = 0, SC_VS = 73728, SC_ST = 92160, SC_END = 125952;
static_assert(SC_END <= LDS_BYTES, "scan LDS map");
__device__ __forceinline__ int scan_row0(int step, int dir, int b) {
    if (step < 2) { const int c = dir == 0 ? step : 1 - step; return RLAT + b * CTXL + c * 128; }
    const int c = dir == 0 ? step - 2 : 33 - step; return b * SEQ + c * 128;
}
typedef short s16x4_t __attribute__((ext_vector_type(4)));
__device__ __forceinline__ bf16x8 tr_frag(const LAS unsigned char* p) {
    const s16x4_t lo = __builtin_bit_cast(s16x4_t, __builtin_amdgcn_ds_read_tr16_b64_v4i16((LAS s16x4_t*)p));
    const s16x4_t hi = __builtin_bit_cast(s16x4_t, __builtin_amdgcn_ds_read_tr16_b64_v4i16((LAS s16x4_t*)(p + 4 * 144)));
    return (bf16x8){lo[0], lo[1], lo[2], lo[3], hi[0], hi[1], hi[2], hi[3]};
}
__device__ __forceinline__ void st16(LAS unsigned char* p, unsigned v) { *(LAS unsigned short*)p = (unsigned short)v; }
__device__ __forceinline__ void tr_write8(LAS unsigned char* base, u32x4 w) {
    st16(base, w.x & 0xffffu); st16(base + 272, w.x >> 16); st16(base + 2 * 272, w.y & 0xffffu); st16(base + 3 * 272, w.y >> 16);
    st16(base + 4 * 272, w.z & 0xffffu); st16(base + 5 * 272, w.z >> 16); st16(base + 6 * 272, w.w & 0xffffu); st16(base + 7 * 272, w.w >> 16);
}
__device__ __forceinline__ void scan_phase(int wave_s, LAS unsigned char* lds, const bf16_t* QR, const bf16_t* KR, const bf16_t* VR, bf16_t* O, const float* dlogit) {
    const Ids I = make_ids(wave_s);
    const int tid = I.tid, lane = I.lane, wave = I.wave, r32 = lane & 31, hi = lane >> 5;
    const int qb = wave & 3, dvb = wave >> 2, sdv = wave & 1, sdb0 = wave >> 1;
    const int srow = tid >> 3, sch = tid & 7;
    const int qloc = 32 * qb + r32;
    const int trb = (hi * 8 + ((lane & 15) >> 2)) * 144 + (((lane >> 4) & 1) * 16 + (lane & 3) * 4) * 2;
    for (int u = I.vcu; u < 256; u += I.G) {
        const int slice = u & 7, h = (u >> 3) & 3, b = u >> 5;
        for (int dir = 0; dir < 2; ++dir) {
            const float lg2 = -__log2f(1.0f + __expf(-dlogit[dir * 4 + h]));
            const float gC = exp2f(128.0f * lg2);
            const float e0 = dir == 0 ? (float)(127 - srow) : (float)srow, e1 = dir == 0 ? (float)(63 - srow) : (float)(srow + 64);
            const float vz0 = exp2f(lg2 * e0), vz1 = exp2f(lg2 * e1);
            const float fin = exp2f(lg2 * (dir == 0 ? (float)(qloc - 127) : (float)(-qloc)));
            for (int i = tid; i < (SC_END - SC_ST) / 16; i += 512) *(LAS u32x4*)(lds + SC_ST + i * 16) = (u32x4){0u, 0u, 0u, 0u};
            f32x16 st0, st1, sa0, sa1, ca;
#pragma unroll
            for (int r = 0; r < 16; ++r) { st0[r] = 0.f; st1[r] = 0.f; sa0[r] = 0.f; sa1[r] = 0.f; ca[r] = 0.f; }
            int row0 = scan_row0(0, dir, b);
            const size_t qoff = (size_t)srow * 1024 + h * 256 + sch * 8, voff = (size_t)srow * 2048 + h * 512 + slice * 64 + sch * 8;
            u32x4 gq0, gq1, gk0, gk1, gv0, gv1, go0 = {0u, 0u, 0u, 0u}, go1 = go0;
            { const bf16_t* qp = QR + (size_t)row0 * 1024 + qoff; const bf16_t* kp = KR + (size_t)row0 * 1024 + qoff; const bf16_t* vp = VR + (size_t)row0 * 2048 + voff;
              gq0 = *(const u32x4*)qp; gq1 = *(const u32x4*)(qp + 64 * 1024); gk0 = *(const u32x4*)kp; gk1 = *(const u32x4*)(kp + 64 * 1024); gv0 = *(const u32x4*)vp; gv1 = *(const u32x4*)(vp + 64 * 2048); }
            for (int step = 0; step < 34; ++step) {
                const int row_next = scan_row0(step + 1 < 34 ? step + 1 : step, dir, b);
#pragma unroll
                for (int dc = 0; dc < 4; ++dc) {
                    { const u32x4 a0 = gq0, a1 = gq1, b0 = gk0, b1 = gk1;
                      LAS unsigned char* qd = lds + (dc & 1) * SC_BUF + SC_QD + srow * 144 + sch * 16; *(LAS u32x4*)qd = a0; *(LAS u32x4*)(qd + 64 * 144) = a1;
                      LAS unsigned char* kd = lds + (dc & 1) * SC_BUF + SC_KD + srow * 144 + sch * 16; *(LAS u32x4*)kd = b0; *(LAS u32x4*)(kd + 64 * 144) = b1;
                      if (dc == 0) { LAS unsigned char* vd = lds + SC_VS + srow * 144 + sch * 16; *(LAS u32x4*)vd = scale8(gv0, vz0); *(LAS u32x4*)(vd + 64 * 144) = scale8(gv1, vz1); } }
                    __syncthreads();
                    if (dc == 0 && dir == 1) { const bf16_t* op = O + (size_t)(row0 + srow) * 2048 + h * 512 + slice * 64 + sch * 8; go0 = *(const u32x4*)op; go1 = *(const u32x4*)(op + (size_t)64 * 2048); }
                    if (dc < 3) { const bf16_t* qp = QR + (size_t)row0 * 1024 + qoff + (dc + 1) * 64; const bf16_t* kp = KR + (size_t)row0 * 1024 + qoff + (dc + 1) * 64;
                        gq0 = *(const u32x4*)qp; gq1 = *(const u32x4*)(qp + 64 * 1024); gk0 = *(const u32x4*)kp; gk1 = *(const u32x4*)(kp + 64 * 1024); }
                    else { const bf16_t* qp = QR + (size_t)row_next * 1024 + qoff; const bf16_t* kp = KR + (size_t)row_next * 1024 + qoff; const bf16_t* vp = VR + (size_t)row_next * 2048 + voff;
                        gq0 = *(const u32x4*)qp; gq1 = *(const u32x4*)(qp + 64 * 1024); gk0 = *(const u32x4*)kp; gk1 = *(const u32x4*)(kp + 64 * 1024); gv0 = *(const u32x4*)vp; gv1 = *(const u32x4*)(vp + 64 * 2048); }
                    bf16x8 bq[4];
#pragma unroll
                    for (int ks = 0; ks < 4; ++ks) bq[ks] = *(const LAS bf16x8*)(lds + (dc & 1) * SC_BUF + SC_QD + qloc * 144 + ks * 32 + hi * 16);
#pragma unroll
                    for (int ks = 0; ks < 4; ++ks) {
                        const bf16x8 k0 = *(const LAS bf16x8*)(lds + (dc & 1) * SC_BUF + SC_KD + (64 * dvb + kappa(r32)) * 144 + ks * 32 + hi * 16);
                        const bf16x8 k1 = *(const LAS bf16x8*)(lds + (dc & 1) * SC_BUF + SC_KD + (64 * dvb + 32 + kappa(r32)) * 144 + ks * 32 + hi * 16);
                        const bf16x8 sf = *(const LAS bf16x8*)(lds + SC_ST + (32 * dvb + r32) * 528 + (64 * dc + 16 * ks + 8 * hi) * 2);
                        sa0 = mfma32(k0, bq[ks], sa0); sa1 = mfma32(k1, bq[ks], sa1); ca = mfma32(sf, bq[ks], ca);
                    }
                    if ((dc & 1) == dvb) {
                        f32x16 s = (dc < 2) ? st0 : st1;
                        s = s * gC;
                        const LAS unsigned char* ka = lds + (dc & 1) * SC_BUF + SC_KD + trb + (sdb0 & 1) * 64;
                        const LAS unsigned char* va = lds + SC_VS + trb + sdv * 64;
                        f32x16 s2;
#pragma unroll
                        for (int r = 0; r < 16; ++r) s2[r] = 0.f;
#pragma unroll
                        for (int ks = 0; ks < 8; ks += 2) { const bf16x8 a = tr_frag(ka + ks * 16 * 144), bv = tr_frag(va + ks * 16 * 144), a2 = tr_frag(ka + (ks + 1) * 16 * 144), bv2 = tr_frag(va + (ks + 1) * 16 * 144);
                            s = mfma32(a, bv, s); s2 = mfma32(a2, bv2, s2); }
                        s = s + s2;
                        if (dc < 2) st0 = s; else st1 = s;
                    }
                }
#pragma unroll
                for (int x = 0; x < 2; ++x)
#pragma unroll
                    for (int s2 = 0; s2 < 2; ++s2) {
                        const int key0 = 64 * dvb + 32 * x + 16 * s2 + 8 * hi; float v[8];
#pragma unroll
                        for (int e = 0; e < 8; ++e) { const float sv = x == 0 ? sa0[8 * s2 + e] : sa1[8 * s2 + e]; const bool keep = dir == 0 ? (key0 + e <= qloc) : (key0 + e > qloc); v[e] = keep ? sv : 0.f; }
                        u32x4 w; w.x = pk2(v[0], v[1]); w.y = pk2(v[2], v[3]); w.z = pk2(v[4], v[5]); w.w = pk2(v[6], v[7]);
                        *(LAS u32x4*)(lds + SC_SQ + qloc * 272 + key0 * 2) = w;
                    }
                ca = ca * gC;
                __syncthreads();
#pragma unroll
                for (int x = 0; x < 2; ++x)
#pragma unroll
                    for (int g = 0; g < 4; ++g) { const int d = 32 * (sdb0 + 4 * x) + 8 * g + 4 * hi; u32x2 w;
                        if (x == 0) { w.x = pk2(st0[4 * g], st0[4 * g + 1]); w.y = pk2(st0[4 * g + 2], st0[4 * g + 3]); } else { w.x = pk2(st1[4 * g], st1[4 * g + 1]); w.y = pk2(st1[4 * g + 2], st1[4 * g + 3]); }
                        *(LAS u32x2*)(lds + SC_ST + (32 * sdv + r32) * 528 + d * 2) = w; }
                { const LAS unsigned char* va = lds + SC_VS + trb + dvb * 64;
                  f32x16 c2;
#pragma unroll
                  for (int r = 0; r < 16; ++r) c2[r] = 0.f;
#pragma unroll
                  for (int ks = 0; ks < 8; ks += 2) { const bf16x8 a = tr_frag(va + ks * 16 * 144), a2 = tr_frag(va + (ks + 1) * 16 * 144);
                      const bf16x8 bs = *(const LAS bf16x8*)(lds + SC_SQ + qloc * 272 + ks * 32 + hi * 16), bs2 = *(const LAS bf16x8*)(lds + SC_SQ + qloc * 272 + (ks + 1) * 32 + hi * 16);
                      ca = mfma32(a, bs, ca); c2 = mfma32(a2, bs2, c2); }
                  ca = ca + c2; }
#pragma unroll
                for (int g = 0; g < 4; ++g) { const f32x4 v = {ca[4 * g] * fin, ca[4 * g + 1] * fin, ca[4 * g + 2] * fin, ca[4 * g + 3] * fin}; *(LAS f32x4*)(lds + SC_BUF + qloc * 272 + (32 * dvb + 8 * g + 4 * hi) * 4) = v; }
#pragma unroll
                for (int r = 0; r < 16; ++r) { sa0[r] = 0.f; sa1[r] = 0.f; ca[r] = 0.f; }
                __syncthreads();
                { bf16_t* op = O + (size_t)(row0 + srow) * 2048 + h * 512 + slice * 64 + sch * 8;
                  const LAS unsigned char* os = lds + SC_BUF + srow * 272 + sch * 32;
                  f32x4 x0 = *(const LAS f32x4*)os, x1 = *(const LAS f32x4*)(os + 16), y0 = *(const LAS f32x4*)(os + 64 * 272), y1 = *(const LAS f32x4*)(os + 64 * 272 + 16);
                  if (dir == 1) {
                      x0[0] += bflo(go0.x); x0[1] += bfhi(go0.x); x0[2] += bflo(go0.y); x0[3] += bfhi(go0.y); x1[0] += bflo(go0.z); x1[1] += bfhi(go0.z); x1[2] += bflo(go0.w); x1[3] += bfhi(go0.w);
                      y0[0] += bflo(go1.x); y0[1] += bfhi(go1.x); y0[2] += bflo(go1.y); y0[3] += bfhi(go1.y); y1[0] += bflo(go1.z); y1[1] += bfhi(go1.z); y1[2] += bflo(go1.w); y1[3] += bfhi(go1.w); }
                  *(u32x4*)op = pack8(x0, x1); *(u32x4*)(op + (size_t)64 * 2048) = pack8(y0, y1); }
                row0 = row_next;
            }
        }
    }
}

#define XB_TMO      128
#define XB_XCNT(j)  (256  + 64 * (j))
#define XB_XSUB(j)  (1280 + 64 * (j))
#define XB_XGEN(j)  (2304 + 64 * (j))
#define XB_TOP      3328
#define XB_TOPGEN   3392
#define XCD_BAR_WORDS 3456
#define XB_SPIN_CAP (1u << 21)

__device__ __forceinline__ unsigned xb_ld(unsigned* p)              { return __hip_atomic_load(p, __ATOMIC_RELAXED, __HIP_MEMORY_SCOPE_AGENT); }
__device__ __forceinline__ unsigned xb_add(unsigned* p, unsigned v) { return __hip_atomic_fetch_add(p, v, __ATOMIC_RELAXED, __HIP_MEMORY_SCOPE_AGENT); }
__device__ __forceinline__ unsigned xb_xcc_id() { return (unsigned)__builtin_amdgcn_s_getreg((3 << 11) | 20) & 0xFu; }
#define XB_SPIN(cond, bar) do { unsigned _sp = 0; while (cond) { __builtin_amdgcn_s_sleep(1); \
    if ((++_sp & 255u) == 0u) { if (xb_ld(&(bar)[XB_TMO])) break; if (_sp > XB_SPIN_CAP) { atomicAdd(&(bar)[XB_TMO], 1u); break; } } } } while (0)

struct XcdBarrier {
    unsigned* bar; unsigned x;
    bool w0;
    volatile LAS unsigned* st;
};

__device__ __forceinline__ XcdBarrier xcd_barrier_post(unsigned* bar, volatile LAS unsigned* st) {
    XcdBarrier b; b.bar = bar; b.x = xb_xcc_id(); b.st = st;
    if (threadIdx.x == 0) (void)xb_add(&bar[XB_XCNT(b.x)], 1u);
    return b;
}
__device__ __forceinline__ void xcd_barrier_complete(unsigned* bar, unsigned x, unsigned& nloc, unsigned& nx) {
    const unsigned G = gridDim.x * gridDim.y * gridDim.z;
    unsigned sum, cnt, mine, sp = 0u;
    for (;;) {
        sum = 0u; cnt = 0u; mine = 0u;
#pragma unroll
        for (unsigned j = 0; j < 16; ++j) { const unsigned c = xb_ld(&bar[XB_XCNT(j)]); sum += c; cnt += (c > 0u) ? 1u : 0u; mine = (j == x) ? c : mine; }
        if (sum == G) break;
        __builtin_amdgcn_s_sleep(1);
        if ((++sp & 255u) == 0u) { if (xb_ld(&bar[XB_TMO])) break; if (sp > XB_SPIN_CAP) { atomicAdd(&bar[XB_TMO], 1u); break; } }
    }
    nloc = mine > 0u ? mine : 1u; nx = cnt > 0u ? cnt : 1u;
}

__device__ __forceinline__ void xcd_barrier(const XcdBarrier& b) {
    asm volatile("s_waitcnt vmcnt(0)" ::: "memory");
    __syncthreads();
    if (b.w0 && hw_lane() == 0) {
        unsigned* bar = b.bar;
        __builtin_amdgcn_s_waitcnt(0);
        unsigned nloc = b.st[0], nx = b.st[1];
        const unsigned old = xb_add(&bar[XB_XSUB(b.x)], 1u);
        const unsigned gen = old / nloc;
        if (old + 1u == (gen + 1u) * nloc) {
            __builtin_amdgcn_fence(__ATOMIC_RELEASE, "agent");
            asm volatile("s_waitcnt vmcnt(0)" ::: "memory");
            const unsigned og = xb_add(&bar[XB_TOP], 1u);
            const unsigned tg = og / nx;
            if (og + 1u == (tg + 1u) * nx) xb_add(&bar[XB_TOPGEN], 1u);
            else XB_SPIN(xb_ld(&bar[XB_TOPGEN]) == tg, bar);
            __builtin_amdgcn_fence(__ATOMIC_ACQUIRE, "agent");
            xb_add(&bar[XB_XGEN(b.x)], 1u);
            asm volatile("s_waitcnt vmcnt(0)" ::: "memory");
        } else {
            XB_SPIN(xb_ld(&bar[XB_XGEN(b.x)]) == gen, bar);
            __builtin_amdgcn_fence(__ATOMIC_ACQUIRE, "agent");
            asm volatile("s_waitcnt vmcnt(0)" ::: "memory");
        }
    }
    __syncthreads();
}

struct Args { const float* in[16]; float* out; unsigned char* ws; };
__global__ void __launch_bounds__(512, 2) mega_fwd(Args a) {
    extern __shared__ __attribute__((aligned(16))) unsigned char lds_raw[];
    LAS unsigned char* lds = (LAS unsigned char*)lds_raw;
    cg::grid_group grid = cg::this_grid();
    const int wave_s = __builtin_amdgcn_readfirstlane((int)threadIdx.x >> 6);
    volatile LAS unsigned* bst = (volatile LAS unsigned*)(lds + LDS_BYTES - 16);
    if (threadIdx.x == 0) { bst[0] = 0u; bst[1] = 0u; }
    __syncthreads();
    XcdBarrier bar = xcd_barrier_post((unsigned*)(a.ws + WS_BAR), bst);
    bar.w0 = wave_s == 0;
#define GSYNC() xcd_barrier(bar)
    const float* x = a.in[0]; const float* cvec = a.in[1]; const float* ctx = a.in[2]; const float* cctx = a.in[3]; const float* ada_w = a.in[4]; const float* ada_b = a.in[5];
    const float* w_qkv = a.in[6]; const float* w_ao = a.in[7]; const float* a_lam = a.in[8]; const float* a_subg = a.in[9]; const float* w_rin = a.in[10]; const float* w_ro = a.in[11];
    const float* r_decay = a.in[12]; const float* w_m1 = a.in[13]; const float* w_m2 = a.in[14]; const float* fin_g = a.in[15];
    float* out = a.out; unsigned char* ws = a.ws;
    float* MOD = (float*)(ws + WS_MOD); float* ROPE = (float*)(ws + WS_ROPE);
    bf16_t* WB = (bf16_t*)(ws + WS_W); bf16_t* U = (bf16_t*)(ws + WS_U); bf16_t* QB = (bf16_t*)(ws + WS_Q); bf16_t* KB = (bf16_t*)(ws + WS_K);
    bf16_t* VB = (bf16_t*)(ws + WS_V); bf16_t* OB = (bf16_t*)(ws + WS_O); float* HC = (float*)(ws + WS_HC); bf16_t* HID = (bf16_t*)(ws + WS_HID);
    bf16_t* W1T = QB; bf16_t* W2T = QB + (size_t)DFF * DM;
    float* PART = (float*)(ws + WS_Q + 16 * MiB);

    ada_phase(wave_s, lds, cvec, cctx, ada_w, ada_b, MOD);
    rope_tables(ROPE);
    conv_two(wave_s, lds, w_qkv, DM, 3 * DM, WB, 1, w_ao, DM, DM, WB + (size_t)3 * DM * DM, (int)gridDim.x / 2);
    if (threadIdx.x == 0) { unsigned nloc_, nx_; xcd_barrier_complete(bar.bar, bar.x, nloc_, nx_); bst[0] = nloc_; bst[1] = nx_; }
    __syncthreads();
    if (a.ws == nullptr) grid.sync();
    GSYNC();

    for (int layer = 0; layer < DEPTH; ++layer) {
        const bool is_ret = (layer & 1) != 0; const int j = layer >> 1;
        const bool need_ctx = layer < DEPTH - 1;
        const int Mres = need_ctx ? RALL : RLAT;
        const float* hl_in = layer == 0 ? x : out; const float* hc_in = layer == 0 ? ctx : HC;
        const float* modL = MOD + (size_t)layer * 9 * NMODC;
        EpiP ep{};
        if (layer == 0) norm_rows(wave_s, hl_in, hc_in, modL, 0, DM, U, RALL);
        else norm_rows(wave_s, hl_in, hc_in, modL, 0, DM, U, RALL, PART, MOD + ((size_t)(layer - 1) * 9 + 8) * NMODC + 5 * DM, HC);
        if (!is_ret) { if (layer > 0) conv_two(wave_s, lds, w_qkv + (size_t)j * DM * 3 * DM, DM, 3 * DM, WB, 1, w_ao + (size_t)j * DM * DM, DM, DM, WB + (size_t)3 * DM * DM); }
        else conv_two(wave_s, lds, w_rin + (size_t)j * DM * 6 * DM, DM, 6 * DM, WB, 2, w_ro + (size_t)j * 2 * DM * DM, 2 * DM, DM, WB + (size_t)6 * DM * DM);
        GSYNC();
        if (!is_ret) {
            ep.o0 = QB; ep.o1 = KB; ep.o2 = VB; ep.rc = ROPE; ep.rs = ROPE + 1024;
            run_gemm<0>(wave_s, lds, U, WB, RALL, 3 * DM, DM, ep);
            GSYNC();
            const float lambda_init = layer == 0 ? 0.2f : 0.47071301834358397f;
            attn_phase(wave_s, lds, QB, KB, VB, OB, a_lam + j * 256, a_subg + j * 128, lambda_init, need_ctx);
            GSYNC();
            ep.hin_l = hl_in; ep.hin_c = hc_in; ep.hout_l = out; ep.hout_c = HC; ep.gate = modL + 2 * DM;
            ep.part = PART;
            run_gemm<2>(wave_s, lds, OB, WB + (size_t)3 * DM * DM, Mres, DM, DM, ep, need_ctx);
        } else {
            ep.o0 = QB; ep.o1 = KB; ep.o2 = VB; ep.rc = ROPE + 10240; ep.rs = ROPE + 10240;
            run_gemm<1>(wave_s, lds, U, WB, RALL, 4 * DM, DM, ep);
            GSYNC();
            scan_phase(wave_s, lds, QB, KB, VB, OB, r_decay + j * 8);
            GSYNC();
            gn_rows(wave_s, OB, Mres);
            GSYNC();
            ep.o0 = OB;
            run_gemm<4>(wave_s, lds, U, WB + (size_t)4 * DM * DM, Mres, 2 * DM, DM, ep);
            GSYNC();
            ep.hin_l = hl_in; ep.hin_c = hc_in; ep.hout_l = out; ep.hout_c = HC; ep.gate = modL + 2 * DM;
            ep.part = PART;
            run_gemm<2>(wave_s, lds, OB, WB + (size_t)6 * DM * DM, Mres, DM, 2 * DM, ep, need_ctx);
        }
        GSYNC();
        if (need_ctx) norm_rows(wave_s, out, hc_in, modL, 3 * DM, 4 * DM, U, Mres, PART, modL + 8 * NMODC + 2 * DM, HC);
        else norm_rows(wave_s, out, HC, modL, 3 * DM, 4 * DM, U, Mres);
        conv_two(wave_s, lds, w_m1 + (size_t)layer * DM * DFF, DM, DFF, W1T, 0, w_m2 + (size_t)layer * DFF * DM, DFF, DM, W2T);
        GSYNC();
        ep.o0 = HID;
        run_gemm<3>(wave_s, lds, U, W1T, Mres, DFF, DM, ep);
        GSYNC();
        ep.hin_l = out; ep.hin_c = HC; ep.hout_l = out; ep.hout_c = HC; ep.gate = modL + 5 * DM;
        ep.part = PART;
        run_gemm<2>(wave_s, lds, HID, W2T, Mres, DM, DFF, ep, need_ctx);
        GSYNC();
    }
    final_norm(wave_s, out, fin_g);
}

extern "C" void kernel_launch(void* const* d_in, const int* in_sizes, int n_in, void* d_out, int out_size, void* d_ws, size_t ws_size, hipStream_t stream) {
    static int grid = 0;
    if (grid == 0) {
        if (n_in != 16 || in_sizes[0] != RLAT * DM || out_size != RLAT * DM || ws_size < WS_END) {
            fprintf(stderr, "kernel_launch: unexpected shapes (n_in %d, in0 %d, out %d, ws %zu < %zu); nothing launched\n", n_in, n_in > 0 ? in_sizes[0] : -1, out_size, ws_size, (size_t)WS_END); grid = -1; return; }
        int dev = 0, cus = 0, per_cu = 0;
        if (hipGetDevice(&dev) != hipSuccess || hipDeviceGetAttribute(&cus, hipDeviceAttributeMultiprocessorCount, dev) != hipSuccess) { fprintf(stderr, "kernel_launch: device query failed\n"); grid = -1; return; }
        if (hipFuncSetAttribute((const void*)mega_fwd, hipFuncAttributeMaxDynamicSharedMemorySize, LDS_BYTES) != hipSuccess) { fprintf(stderr, "kernel_launch: hipFuncSetAttribute failed\n"); grid = -1; return; }
        if (hipOccupancyMaxActiveBlocksPerMultiprocessor(&per_cu, (const void*)mega_fwd, 512, LDS_BYTES) != hipSuccess || per_cu < 1) { fprintf(stderr, "kernel_launch: occupancy query says %d blocks per CU\n", per_cu); per_cu = 1; }
        (void)hipGetLastError();
        grid = cus;
    }
    if (grid < 0) return;
    Args a{};
    for (int i = 0; i < 16; ++i) a.in[i] = (const float*)d_in[i];
    a.out = (float*)d_out; a.ws = (unsigned char*)d_ws;
    if (hipMemsetAsync((unsigned char*)d_ws + WS_BAR, 0, 16384, stream) != hipSuccess) { fprintf(stderr, "kernel_launch: hipMemsetAsync failed\n"); return; }
    void* args[] = {&a};
    const hipError_t e = hipLaunchCooperativeKernel((const void*)mega_fwd, dim3(grid), dim3(512), args, LDS_BYTES, stream);
    if (e != hipSuccess) fprintf(stderr, "kernel_launch: cooperative launch failed: %s (grid %d)\n", hipGetErrorString(e), grid);
}
```

```cpp
#include <hip/hip_runtime.h>
#include <hip/hip_cooperative_groups.h>
#include <cstdio>
#include <cstdint>
namespace cg = cooperative_groups;
namespace pg8 {
#define PG8_LAS __attribute__((address_space(3)))
typedef unsigned short bf16_t;
typedef short bf16x8 __attribute__((ext_vector_type(8)));
typedef float f32x4 __attribute__((ext_vector_type(4)));
typedef unsigned u32x4 __attribute__((ext_vector_type(4)));
constexpr int BM = 256, BK = 64, HALF = 128, HTB = HALF * BK * 2  , STAGE_BYTES = 8 * HTB, NXCD = 8, WGM = 4;

__host__ __device__ __forceinline__ int lds_byte(int r, int c) { const int st = (r >> 4) * 2 + (c >> 5), rr = r & 15, cc = c & 31, ob = rr * 64 + cc * 2; return st * 1024 + (ob ^ (((ob >> 9) & 1) << 5)); }
__host__ __device__ __forceinline__ void stage_rc(int b, int& R, int& C) { const int st = b / 1024, sb = b % 1024, swz = sb ^ (((sb >> 9) & 1) << 5); R = (st >> 1) * 16 + swz / 64; C = (st & 1) * 32 + (swz % 64) / 2; }
__host__ __device__ __forceinline__ int perm32(int rho) { const int n = rho >> 4, i = rho & 15; return 8 * (i >> 2) + 4 * n + (i & 3); }

struct Unit { int pm, pn, kofs, nt, sp; };
struct Gemm { const bf16_t* A; const bf16_t* Bt; int M, N, K; };

struct StaticOrder {
    int nM, nN, nwg, G, c, ntK, nsplit, nextra, mext;
    __host__ __device__ __forceinline__ void init(int M, int N, int G_, int c_) { nM = M / BM; nN = N / BM; nwg = nM * nN; G = G_; c = c_; ntK = 0; nsplit = 0; nextra = 0; mext = 0; }
    __host__ __device__ __forceinline__ bool next(int i, Unit& u) const {
        const long L = (long)i * G + c;
        const bool ext = L >= nwg; const int L2 = (int)(L - nwg);
        if (ext && (nsplit == 0 || L2 >= nextra * nN * nsplit)) return false;
        int pm, pn, kofs = 0, ntu = ntK, sp = -1;
        if (ext) { pm = mext + L2 / (nN * nsplit); pn = (L2 / nsplit) % nN; sp = L2 % nsplit; ntu = ntK / nsplit; kofs = sp * ntu * BK; }
        else {
            int wgid = (int)L; { const int q = nwg / NXCD, r = nwg % NXCD, xcd = wgid % NXCD, off = wgid / NXCD; wgid = (xcd < r ? xcd * (q + 1) : r * (q + 1) + (xcd - r) * q) + off; }
            const int nig = WGM * nN, gid = wgid / nig, fm = gid * WGM, gsz = (nM - fm) < WGM ? (nM - fm) : WGM;
            pm = fm + ((wgid % nig) % gsz); pn = (wgid % nig) / gsz;
        }
        u.pm = pm; u.pn = pn; u.kofs = kofs; u.nt = ntu; u.sp = sp; return true;
    }
    __device__ __forceinline__ void a_ready(const Unit&) const {}
    __device__ __forceinline__ void done(const Unit&) const {}
};

__device__ __forceinline__ unsigned cvt_pk_bf16(float lo, float hi) { unsigned r; asm volatile("v_cvt_pk_bf16_f32 %0, %1, %2" : "=v"(r) : "v"(lo), "v"(hi)); return r; }
typedef float f32x2 __attribute__((ext_vector_type(2)));
template <class Epi, class Sched, bool ALIGN_EPI = false, bool SP2 = false>
__device__ __forceinline__ void gemm_phase(int wave_s, PG8_LAS unsigned char* lds, const Gemm g, const Sched& S, const Epi& E) {
    int tid_; asm volatile("v_mbcnt_lo_u32_b32 %0, -1, 0\n\tv_mbcnt_hi_u32_b32 %0, -1, %0" : "=v"(tid_)); tid_ += wave_s * 64;
    const int tid = tid_, wid = __builtin_amdgcn_readfirstlane(tid >> 6), lane = tid & 63, wr = wid >> 2, wc = wid & 3, fr = lane & 15, fq = lane >> 4;
    const int K = g.K;
    unsigned voffA[2], voffB[2];
#pragma unroll
    for (int i = 0; i < 2; ++i) { int R, C; stage_rc(tid * 16 + i * 8192, R, C); const int Rb = Epi::PERM ? ((R & ~31) + perm32(R & 31)) : R;
        voffA[i] = (unsigned)(R * K + C) * 2u; voffB[i] = (unsigned)(Rb * K + C) * 2u; }
    const size_t kstep = (size_t)(BK * 2);
    const size_t hstep = (size_t)HALF * K * 2;
    const size_t tstep = 2 * hstep;
    const unsigned ldsw = (unsigned)wid * 1024u;
    const int aoff = lds_byte(wr * 64 + fr, fq * 8), boff = lds_byte(wc * 32 + fr, fq * 8);
#define PG8_SA(b, h) (((b) * 2 + (h)) * HTB)
#define PG8_SB(b, h) ((4 + (b) * 2 + (h)) * HTB)
#define PG8_STAGE(bufoff, gbase, voff) do { _Pragma("unroll") for (int _i = 0; _i < 2; ++_i) \
        __builtin_amdgcn_global_load_lds((const unsigned*)((const char*)(gbase) + (voff)[_i]), (PG8_LAS unsigned*)(lds + (bufoff) + ldsw + _i * 8192), 16, 0, 0); } while (0)
#define PG8_LDA(dst, b, h) do { _Pragma("unroll") for (int m = 0; m < 4; ++m) _Pragma("unroll") for (int k = 0; k < 2; ++k) dst[m][k] = *(const PG8_LAS bf16x8*)(lds + PG8_SA(b, h) + aoff + m * 2048 + k * 1024); } while (0)
#define PG8_LDB(dst, b, h) do { _Pragma("unroll") for (int n = 0; n < 2; ++n) _Pragma("unroll") for (int k = 0; k < 2; ++k) dst[n][k] = *(const PG8_LAS bf16x8*)(lds + PG8_SB(b, h) + boff + n * 2048 + k * 1024); } while (0)
#define PG8_MMA(ai, bj, At, Bt) do { __builtin_amdgcn_s_setprio(1); _Pragma("unroll") for (int m = 0; m < 4; ++m) _Pragma("unroll") for (int n = 0; n < 2; ++n) _Pragma("unroll") for (int k = 0; k < 2; ++k) \
        acc[ai][bj][m][n] = __builtin_amdgcn_mfma_f32_16x16x32_bf16(Bt[n][k], At[m][k], acc[ai][bj][m][n], 0, 0, 0); __builtin_amdgcn_s_setprio(0); } while (0)
#define PG8_WAIT_V(n) asm volatile("s_waitcnt vmcnt(" #n ")" ::: "memory")
#define PG8_WAIT_L(n) asm volatile("s_waitcnt lgkmcnt(" #n ")" ::: "memory")
#define PG8_BAR __builtin_amdgcn_s_barrier()
#define PG8_SCHED __builtin_amdgcn_sched_barrier(0)
    Unit cur, nxt; int ui = 0;
    if (!S.next(0, cur)) return;
    f32x4 acc[2][2][4][2];
#pragma unroll
    for (int a = 0; a < 2; ++a)
#pragma unroll
        for (int b = 0; b < 2; ++b)
#pragma unroll
            for (int m = 0; m < 4; ++m)
#pragma unroll
                for (int n = 0; n < 2; ++n) acc[a][b][m][n] = (f32x4){0.f, 0.f, 0.f, 0.f};
    bf16x8 At[4][2], B0[2][2], B1[2][2];
    const char* cA = (const char*)g.A + (size_t)cur.pm * tstep + (size_t)cur.kofs * 2; const char* cB = (const char*)g.Bt + (size_t)cur.pn * tstep + (size_t)cur.kofs * 2;
    S.a_ready(cur);
    if constexpr (SP2) {
        PG8_STAGE(PG8_SB(0, 0), cB, voffB); PG8_STAGE(PG8_SB(0, 1), cB + hstep, voffB); PG8_STAGE(PG8_SA(0, 0), cA, voffA); PG8_STAGE(PG8_SA(0, 1), cA + hstep, voffA);
        if (wr == 1) PG8_BAR;
        PG8_WAIT_V(2); PG8_BAR;
        PG8_STAGE(PG8_SB(1, 0), cB + kstep, voffB); PG8_STAGE(PG8_SA(1, 0), cA + kstep, voffA); PG8_STAGE(PG8_SB(1, 1), cB + hstep + kstep, voffB);
        PG8_WAIT_V(6); PG8_BAR;
    } else {
        PG8_STAGE(PG8_SB(0, 0), cB, voffB); PG8_STAGE(PG8_SA(0, 0), cA, voffA); PG8_STAGE(PG8_SB(0, 1), cB + hstep, voffB); PG8_STAGE(PG8_SA(0, 1), cA + hstep, voffA);
        if (wr == 1) PG8_BAR;
        PG8_WAIT_V(4); PG8_BAR;
        PG8_STAGE(PG8_SB(1, 0), cB + kstep, voffB); PG8_STAGE(PG8_SA(1, 0), cA + kstep, voffA); PG8_STAGE(PG8_SB(1, 1), cB + hstep + kstep, voffB);
        PG8_WAIT_V(6); PG8_BAR;
    }
    for (;;) {
        const bool has_next = S.next(ui + 1, nxt);
        const char* nA = has_next ? (const char*)g.A + (size_t)nxt.pm * tstep + (size_t)nxt.kofs * 2 : cA; const char* nB = has_next ? (const char*)g.Bt + (size_t)nxt.pn * tstep + (size_t)nxt.kofs * 2 : cB;
        const int nt = cur.nt;
        for (int t = 0; t < nt; t += 2) {
            const bool last = (t == nt - 2);
            const char* a1 = cA + (size_t)(t + 1) * kstep;
            const char* a2 = last ? nA : cA + (size_t)(t + 2) * kstep; const char* b2 = last ? nB : cB + (size_t)(t + 2) * kstep;
            const char* a3 = a2 + kstep; const char* b3 = b2 + kstep;
            if (last && has_next) S.a_ready(nxt);
            if constexpr (SP2) {
            PG8_LDB(B0, 0, 0); PG8_LDB(B1, 0, 1); PG8_SCHED; PG8_LDA(At, 0, 0); PG8_STAGE(PG8_SA(1, 1), a1 + hstep, voffA);
            PG8_WAIT_V(8); PG8_WAIT_L(0); PG8_BAR; PG8_MMA(0, 0, At, B0); PG8_MMA(0, 1, At, B1); PG8_BAR; PG8_SCHED;
            PG8_LDA(At, 0, 1); PG8_STAGE(PG8_SB(0, 0), b2, voffB); PG8_STAGE(PG8_SB(0, 1), b2 + hstep, voffB); PG8_STAGE(PG8_SA(0, 0), a2, voffA);
            PG8_WAIT_V(8); PG8_WAIT_L(0); PG8_BAR; PG8_MMA(1, 0, At, B0); PG8_MMA(1, 1, At, B1); PG8_BAR; PG8_SCHED;
            PG8_LDB(B0, 1, 0); PG8_LDB(B1, 1, 1); PG8_SCHED; PG8_LDA(At, 1, 0); PG8_STAGE(PG8_SA(0, 1), a2 + hstep, voffA);
            PG8_WAIT_V(8); PG8_WAIT_L(0); PG8_BAR; PG8_MMA(0, 0, At, B0); PG8_MMA(0, 1, At, B1); PG8_BAR; PG8_SCHED;
            PG8_LDA(At, 1, 1); PG8_STAGE(PG8_SB(1, 0), b3, voffB); PG8_STAGE(PG8_SB(1, 1), b3 + hstep, voffB); PG8_STAGE(PG8_SA(1, 0), a3, voffA);
            PG8_WAIT_V(8); PG8_WAIT_L(0); PG8_BAR; PG8_MMA(1, 0, At, B0); PG8_MMA(1, 1, At, B1); PG8_BAR; PG8_SCHED;
            } else {
            PG8_LDB(B0, 0, 0); PG8_SCHED; PG8_LDA(At, 0, 0); PG8_STAGE(PG8_SA(1, 1), a1 + hstep, voffA);
            PG8_WAIT_L(8); PG8_BAR; PG8_WAIT_L(0); PG8_MMA(0, 0, At, B0); PG8_BAR; PG8_SCHED;
            PG8_LDB(B1, 0, 1); PG8_STAGE(PG8_SB(0, 0), b2, voffB);
            PG8_BAR; PG8_WAIT_L(0); PG8_MMA(0, 1, At, B1); PG8_BAR;
            PG8_LDA(At, 0, 1); PG8_STAGE(PG8_SA(0, 0), a2, voffA);
            PG8_BAR; PG8_WAIT_L(0); PG8_MMA(1, 0, At, B0); PG8_BAR; PG8_SCHED;
            PG8_STAGE(PG8_SB(0, 1), b2 + hstep, voffB);
            PG8_WAIT_V(6); PG8_BAR; PG8_MMA(1, 1, At, B1); PG8_BAR;
            PG8_LDB(B0, 1, 0); PG8_SCHED; PG8_LDA(At, 1, 0); PG8_STAGE(PG8_SA(0, 1), a2 + hstep, voffA);
            PG8_WAIT_L(8); PG8_BAR; PG8_WAIT_L(0); PG8_MMA(0, 0, At, B0); PG8_BAR; PG8_SCHED;
            PG8_LDB(B1, 1, 1); PG8_STAGE(PG8_SB(1, 0), b3, voffB);
            PG8_BAR; PG8_WAIT_L(0); PG8_MMA(0, 1, At, B1); PG8_BAR;
            PG8_LDA(At, 1, 1); PG8_STAGE(PG8_SA(1, 0), a3, voffA);
            PG8_BAR; PG8_WAIT_L(0); PG8_MMA(1, 0, At, B0); PG8_BAR; PG8_SCHED;
            PG8_STAGE(PG8_SB(1, 1), b3 + hstep, voffB);
            PG8_WAIT_V(6); PG8_BAR; PG8_MMA(1, 1, At, B1); PG8_BAR;
            }
        }
        if constexpr (ALIGN_EPI) { if (wr == 0) PG8_BAR; }
        if constexpr (!Epi::AFTER_DRAIN) { E(acc, cur, wr, wc, fr, fq); S.done(cur); }
        if (!has_next) break;
#pragma unroll
        for (int a = 0; a < 2; ++a)
#pragma unroll
            for (int b = 0; b < 2; ++b)
#pragma unroll
                for (int m = 0; m < 4; ++m)
#pragma unroll
                    for (int n = 0; n < 2; ++n) acc[a][b][m][n] = (f32x4){0.f, 0.f, 0.f, 0.f};
        cur = nxt; cA = nA; cB = nB; ++ui;
        if constexpr (ALIGN_EPI) { if (wr == 1) PG8_BAR; }
    }
    PG8_WAIT_V(0);
    if constexpr (!ALIGN_EPI) { if (wr == 0) PG8_BAR; }
    PG8_BAR;
    if constexpr (Epi::AFTER_DRAIN) { E.fused(acc, cur, wr, wc, fr, fq, lds, wid, lane); S.done(cur); }
#undef PG8_SA
#undef PG8_SB
#undef PG8_STAGE
#undef PG8_LDA
#undef PG8_LDB
#undef PG8_MMA
#undef PG8_WAIT_V
#undef PG8_WAIT_L
#undef PG8_BAR
#undef PG8_SCHED
}
}

constexpr int BATCH = 8, SEQ = 4096, DM = 1024, CTXL = 256, DEPTH = 4;
constexpr int RLAT = BATCH * SEQ, RCTX = BATCH * CTXL, RALL = RLAT + RCTX;
constexpr int KEYS = SEQ + CTXL;
constexpr int DFF = 4096, NMODC = 6 * DM;
constexpr float NORM_EPS = 1e-6f;
constexpr float QSCALE = 0.125f * 1.4426950408889634f;

constexpr size_t MiB = 1u << 20;
constexpr size_t WS_MOD = 0;
constexpr size_t WS_BAR = 960 * 1024;
constexpr size_t WS_ROPE = 1 * MiB;
constexpr size_t WS_W = 2 * MiB;
constexpr size_t WS_U = 18 * MiB;
constexpr size_t WS_Q = 86 * MiB;
constexpr size_t WS_K = 154 * MiB;
constexpr size_t WS_V = 222 * MiB;
constexpr size_t WS_O = 358 * MiB;
constexpr size_t WS_HC = 494 * MiB;
constexpr size_t WS_END = 502 * MiB;
constexpr size_t WS_HID = WS_K;
constexpr int LDS_BYTES = 147456;

#define LAS __attribute__((address_space(3)))
typedef unsigned short bf16_t;
typedef short bf16x8 __attribute__((ext_vector_type(8)));
typedef float f32x4 __attribute__((ext_vector_type(4)));
typedef float f32x16 __attribute__((ext_vector_type(16)));
typedef unsigned u32x4 __attribute__((ext_vector_type(4)));
typedef unsigned u32x2 __attribute__((ext_vector_type(2)));

__device__ __forceinline__ unsigned pk2(float lo, float hi) { typedef float f2_t __attribute__((ext_vector_type(2))); typedef __bf16 b2_t __attribute__((ext_vector_type(2))); f2_t v = {lo, hi}; b2_t b = __builtin_convertvector(v, b2_t); return __builtin_bit_cast(unsigned, b); }
__device__ __forceinline__ bf16_t f2bf(float f) { return (bf16_t)(pk2(f, 0.f) & 0xffffu); }
__device__ __forceinline__ float bflo(unsigned w) { return __uint_as_float(w << 16); }
__device__ __forceinline__ float bfhi(unsigned w) { return __uint_as_float(w & 0xffff0000u); }
__device__ __forceinline__ u32x4 pack8(f32x4 lo, f32x4 hi) { u32x4 w; w.x = pk2(lo[0], lo[1]); w.y = pk2(lo[2], lo[3]); w.z = pk2(hi[0], hi[1]); w.w = pk2(hi[2], hi[3]); return w; }
__device__ __forceinline__ u32x4 scale8(u32x4 w, float s) { u32x4 o; o.x = pk2(bflo(w.x) * s, bfhi(w.x) * s); o.y = pk2(bflo(w.y) * s, bfhi(w.y) * s); o.z = pk2(bflo(w.z) * s, bfhi(w.z) * s); o.w = pk2(bflo(w.w) * s, bfhi(w.w) * s); return o; }
__device__ __forceinline__ float xor32_sum(float v) { const auto r = __builtin_amdgcn_permlane32_swap(__float_as_uint(v), __float_as_uint(v), false, false); return __uint_as_float(r[0]) + __uint_as_float(r[1]); }
__device__ __forceinline__ float xor32_max(float v) { const auto r = __builtin_amdgcn_permlane32_swap(__float_as_uint(v), __float_as_uint(v), false, false); return __builtin_fmaxf(__uint_as_float(r[0]), __uint_as_float(r[1])); }
__device__ __forceinline__ float xor16_sum(float v) { const auto r = __builtin_amdgcn_permlane16_swap(__float_as_uint(v), __float_as_uint(v), false, false); return __uint_as_float(r[0]) + __uint_as_float(r[1]); }
template <int CTRL> __device__ __forceinline__ float dpp_sum(float v) { return v + __uint_as_float(__builtin_amdgcn_update_dpp(0u, __float_as_uint(v), CTRL, 0xf, 0xf, true)); }
__device__ __forceinline__ float wave_sum(float v) {
    v = dpp_sum<0xB1>(v);
    v = dpp_sum<0x4E>(v);
    v = dpp_sum<0x141>(v);
    v = dpp_sum<0x140>(v);
    v = xor16_sum(v);
    return xor32_sum(v);
}
__device__ __forceinline__ float silu_f(float x) { return x * __builtin_amdgcn_rcpf(1.0f + __expf(-x)); }
__device__ __forceinline__ f32x16 mfma32(bf16x8 a, bf16x8 b, f32x16 c) { return __builtin_amdgcn_mfma_f32_32x32x16_bf16(a, b, c, 0, 0, 0); }
__device__ __forceinline__ int kappa(int m) { return (m & ~12) | ((m & 4) << 1) | ((m & 8) >> 1); }
__device__ __forceinline__ void rope8(f32x4& lo, f32x4& hi, const f32x4 c, const f32x4 s) {
    float a, b;
    a = lo[0]; b = lo[1]; lo[0] = a * c[0] - b * s[0]; lo[1] = a * s[0] + b * c[0];
    a = lo[2]; b = lo[3]; lo[2] = a * c[1] - b * s[1]; lo[3] = a * s[1] + b * c[1];
    a = hi[0]; b = hi[1]; hi[0] = a * c[2] - b * s[2]; hi[1] = a * s[2] + b * c[2];
    a = hi[2]; b = hi[3]; hi[2] = a * c[3] - b * s[3]; hi[3] = a * s[3] + b * c[3];
}

struct Ids { int tid, lane, wave, vcu, G; };
__device__ __forceinline__ int hw_lane() { int l; asm volatile("v_mbcnt_lo_u32_b32 %0, -1, 0\n\tv_mbcnt_hi_u32_b32 %0, -1, %0" : "=v"(l)); return l; }
__device__ __forceinline__ int hw_tid(int wave_s) { return wave_s * 64 + hw_lane(); }
__device__ __forceinline__ Ids make_ids(int wave_s) {
    Ids I; int t = hw_tid(wave_s); asm volatile("" : "+v"(t));
    I.tid = t; I.lane = t & 63; I.wave = __builtin_amdgcn_readfirstlane(t >> 6); I.G = gridDim.x;
    const int bx = blockIdx.x; I.vcu = (I.G % 8 == 0) ? (bx % 8) * (I.G / 8) + bx / 8 : bx;
    return I;
}

struct EpiP {
    bf16_t* o0; bf16_t* o1; bf16_t* o2;
    const float* rc; const float* rs;
    const float* hin_l; const float* hin_c; float* hout_l; float* hout_c; const float* gate;
    float* part;
};
template <int MODE> struct Epi {
    static constexpr bool PERM = true, AFTER_DRAIN = false;
    EpiP p;
    __device__ __forceinline__ void operator()(const pg8::f32x4 (&acc)[2][2][4][2], const pg8::Unit& u, int wr, int wc, int fr, int fq) const {
        const int upm = u.pm, upn = u.pn, usp = u.sp;
#pragma unroll
        for (int ai = 0; ai < 2; ++ai)
#pragma unroll
            for (int m = 0; m < 4; ++m) {
                int fr_ = fr; asm volatile("" : "+v"(fr_) :: "memory");
                const int row = upm * 256 + ai * 128 + wr * 64 + m * 16 + fr_;
                const bool lat = row < RLAT;
                int b, pos;
                if (lat) { b = row >> 12; pos = row & (SEQ - 1); } else { const int r2 = row - RLAT; b = r2 >> 8; pos = SEQ + (r2 & (CTXL - 1)); }
#pragma unroll
                for (int bj = 0; bj < 2; ++bj) {
                    const int c = upn * 256 + bj * 128 + wc * 32 + 8 * fq;
                    f32x4 lo = acc[ai][bj][m][0], hi = acc[ai][bj][m][1];
                    if constexpr (MODE == 0) {
                        const int sec = c >> 10;
                        if (sec < 2) {
                            const int cc = c & 1023, head = cc >> 7, i = (cc >> 6) & 1, pp = cc & 63;
                            if (lat) { const int pidx = (pp < 32) ? (pos >> 6) : (pos & 63); const int j0 = (pp & 31) >> 1;
                                const f32x4 cs = *(const f32x4*)(p.rc + pidx * 16 + j0), sn = *(const f32x4*)(p.rs + pidx * 16 + j0); rope8(lo, hi, cs, sn); }
                            if (sec == 0) { lo = lo * QSCALE; hi = hi * QSCALE; }
                            bf16_t* dst = (sec == 0 ? p.o0 : p.o1) + ((size_t)((b * 8 + head) * 2 + i) * KEYS + pos) * 64 + pp;
                            *(u32x4*)dst = pack8(lo, hi);
                        } else {
                            const int cc = c - 2048, head = cc >> 7, dv = cc & 127;
                            bf16_t* dst = p.o2 + ((size_t)((b * 8 + head) * 128 + dv)) * KEYS + pos;
                            dst[0] = f2bf(lo[0]); dst[KEYS] = f2bf(lo[1]); dst[2 * KEYS] = f2bf(lo[2]); dst[3 * KEYS] = f2bf(lo[3]);
                            dst[4 * KEYS] = f2bf(hi[0]); dst[5 * KEYS] = f2bf(hi[1]); dst[6 * KEYS] = f2bf(hi[2]); dst[7 * KEYS] = f2bf(hi[3]);
                        }
                    } else if constexpr (MODE == 1) {
                        if (c < 2048) {
                            const int sec = c >> 10, cc = c & 1023, pp = cc & 255;
                            if (lat && p.rc) {
                                const float pf = (float)((pp < 128) ? (pos >> 6) : (pos & 63)); const int j0 = (pp & 127) >> 1;
                                const f32x4 rv = *(const f32x4*)(p.rc + j0) * pf; f32x4 cs, sn;
#pragma unroll
                                for (int t = 0; t < 4; ++t) { cs[t] = __builtin_amdgcn_cosf(rv[t]); sn[t] = __builtin_amdgcn_sinf(rv[t]); }
                                rope8(lo, hi, cs, sn); }
                            if (sec == 1) { lo = lo * 0.0625f; hi = hi * 0.0625f; }
                            bf16_t* dst = (sec == 0 ? p.o0 : p.o1) + (size_t)row * 1024 + cc;
                            *(u32x4*)dst = pack8(lo, hi);
                        } else {
                            bf16_t* dst = p.o2 + (size_t)row * 2048 + (c - 2048);
                            *(u32x4*)dst = pack8(lo, hi);
                        }
                    } else if constexpr (MODE == 2) {
                        if (usp >= 0) {
                            float* pp = p.part + ((size_t)usp * RCTX + (size_t)(row - RLAT)) * DM + c;
                            *(f32x4*)pp = lo; *(f32x4*)(pp + 4) = hi;
                        } else {
                        const float* hin; float* hout; int bidx;
                        if (lat) { hin = p.hin_l + (size_t)row * DM; hout = p.hout_l + (size_t)row * DM; bidx = b; }
                        else { const size_t r2 = (size_t)(row - RLAT); hin = p.hin_c + r2 * DM; hout = p.hout_c + r2 * DM; bidx = 8; }
                        const float* g = p.gate + bidx * NMODC + c;
                        const f32x4 g0 = *(const f32x4*)g, g1 = *(const f32x4*)(g + 4), h0 = *(const f32x4*)(hin + c), h1 = *(const f32x4*)(hin + c + 4);
                        *(f32x4*)(hout + c) = h0 + g0 * lo; *(f32x4*)(hout + c + 4) = h1 + g1 * hi;
                        }
                    } else if constexpr (MODE == 3) {
#pragma unroll
                        for (int j = 0; j < 4; ++j) { const float a = fmaxf(lo[j], 0.f), d = fmaxf(hi[j], 0.f); lo[j] = a * a; hi[j] = d * d; }
                        *(u32x4*)(p.o0 + (size_t)row * DFF + c) = pack8(lo, hi);
                    } else {
                        bf16_t* dst = p.o0 + (size_t)row * 2048 + c;
                        const u32x4 w = *(const u32x4*)dst;
                        lo[0] = silu_f(lo[0]) * bflo(w.x); lo[1] = silu_f(lo[1]) * bfhi(w.x); lo[2] = silu_f(lo[2]) * bflo(w.y); lo[3] = silu_f(lo[3]) * bfhi(w.y);
                        hi[0] = silu_f(hi[0]) * bflo(w.z); hi[1] = silu_f(hi[1]) * bfhi(w.z); hi[2] = silu_f(hi[2]) * bflo(w.w); hi[3] = silu_f(hi[3]) * bfhi(w.w);
                        *(u32x4*)dst = pack8(lo, hi);
                    }
                }
                asm volatile("" ::: "memory");
            }
    }
};

template <int MODE> __device__ __forceinline__ void run_gemm(int wave_s, LAS unsigned char* lds, const bf16_t* A, const bf16_t* Bt, int M, int N, int K, const EpiP& ep, bool split_ctx = false) {
    pg8::Gemm g{A, Bt, M, N, K}; pg8::StaticOrder S; S.init(split_ctx ? RLAT : M, N, (int)gridDim.x, (int)blockIdx.x); S.ntK = K / 64;
    if (split_ctx) { S.nsplit = 4; S.nextra = RCTX / 256; S.mext = RLAT / 256; }
    Epi<MODE> E{ep};
    pg8::gemm_phase<Epi<MODE>, pg8::StaticOrder, true, true>(wave_s, lds, g, S, E);
}

__device__ __forceinline__ int srccol(int mode, int n) {
    if (mode == 1 && n < 2048) { const int base = n & ~63, p = n & 63, half = p >> 5, q = p & 31, j = q >> 1; return base + half * 32 + ((q & 1) ? j + 16 : j); }
    if (mode == 2 && n < 2048) { const int base = n & ~255, p = n & 255, half = p >> 7, q = p & 127, j = q >> 1; return base + half * 128 + ((q & 1) ? j + 64 : j); }
    return n;
}
__device__ __forceinline__ void conv_item(const float* W, int K, int N, bf16_t* WT, int mode, LAS float* scr, int item, int lane) {
    const int nblk = N / 32, kb = item / nblk, nb = item % nblk, k0 = 64 * kb, n0 = 32 * nb;
    const int sc = srccol(mode, n0 + (lane & 31));
#pragma unroll 8
    for (int i = 0; i < 32; ++i) { const int kk = 2 * i + (lane >> 5); scr[kk * 33 + (lane & 31)] = W[(size_t)(k0 + kk) * N + sc]; }
    asm volatile("s_waitcnt lgkmcnt(0)" ::: "memory");
    const int c = lane & 7;
#pragma unroll
    for (int j = 0; j < 4; ++j) { const int n = (lane >> 3) + 8 * j; const LAS float* s = scr + (8 * c) * 33 + n;
        u32x4 o; o.x = pk2(s[0 * 33], s[1 * 33]); o.y = pk2(s[2 * 33], s[3 * 33]); o.z = pk2(s[4 * 33], s[5 * 33]); o.w = pk2(s[6 * 33], s[7 * 33]);
        *(u32x4*)(WT + (size_t)(n0 + n) * K + k0 + 8 * c) = o; }
    asm volatile("s_waitcnt lgkmcnt(0)" ::: "memory");
}
__device__ __forceinline__ void conv_two(int wave_s, LAS unsigned char* lds, const float* W0, int K0, int N0, bf16_t* T0, int mode0, const float* W1, int K1, int N1, bf16_t* T1, int first_block = 0) {
    const Ids I = make_ids(wave_s);
    LAS float* scr = (LAS float*)(lds + I.wave * 16384);
    if ((int)blockIdx.x < first_block) return;
    const int gw = (first_block ? (int)blockIdx.x - first_block : I.vcu) * 8 + I.wave, NGW = (I.G - first_block) * 8;
    const int n0 = (K0 / 64) * (N0 / 32), n1 = (K1 / 64) * (N1 / 32);
    for (int it = gw; it < n0 + n1; it += NGW) {
        if (it < n0) conv_item(W0, K0, N0, T0, mode0, scr, it, I.lane);
        else conv_item(W1, K1, N1, T1, 0, scr, it - n0, I.lane);
    }
}

__device__ __forceinline__ void norm_rows(int wave_s, const float* hl, const float* hc, const float* modL, int shoff, int scoff, bf16_t* U, int nrows, const float* part = nullptr, const float* gate_c = nullptr, float* hc_out = nullptr) {
    const Ids I = make_ids(wave_s);
    const int gw = I.vcu * 8 + I.wave, NGW = I.G * 8;
    for (int grp = gw; grp < RLAT / 4; grp += NGW) {
        const int row0 = grp * 4, bidx = row0 >> 12;
        const float* src = hl + (size_t)row0 * DM + 4 * I.lane;
        const float* sh = modL + bidx * NMODC + shoff + 4 * I.lane; const float* sc = modL + bidx * NMODC + scoff + 4 * I.lane;
        f32x4 v[4][4];
#pragma unroll
        for (int r = 0; r < 4; ++r)
#pragma unroll
            for (int j = 0; j < 4; ++j) v[r][j] = *(const f32x4*)(src + r * DM + 256 * j);
        float rstd[4];
#pragma unroll
        for (int r = 0; r < 4; ++r) { float s = 0.f;
#pragma unroll
            for (int j = 0; j < 4; ++j) s += (v[r][j][0] * v[r][j][0] + v[r][j][1] * v[r][j][1]) + (v[r][j][2] * v[r][j][2] + v[r][j][3] * v[r][j][3]);
            rstd[r] = rsqrtf(wave_sum(s) * (1.0f / DM) + NORM_EPS); }
#pragma unroll
        for (int j = 0; j < 4; ++j) { const f32x4 a = *(const f32x4*)(sc + 256 * j) + 1.0f, bs = *(const f32x4*)(sh + 256 * j);
#pragma unroll
            for (int r = 0; r < 4; ++r) { const f32x4 o = v[r][j] * rstd[r] * a + bs; u32x2 w; w.x = pk2(o[0], o[1]); w.y = pk2(o[2], o[3]); *(u32x2*)(U + (size_t)(row0 + r) * DM + 4 * I.lane + 256 * j) = w; } }
    }
    for (int row = RLAT + gw; row < nrows; row += NGW) {
        const float* src = hc + (size_t)(row - RLAT) * DM;
        const float* sh = modL + 8 * NMODC + shoff; const float* sc = modL + 8 * NMODC + scoff;
        f32x4 v[4]; float s = 0.f;
#pragma unroll
        for (int j = 0; j < 4; ++j) { const int c = 4 * I.lane + 256 * j; v[j] = *(const f32x4*)(src + c);
            if (part) { const float* pp = part + (size_t)(row - RLAT) * DM + c; const size_t ps = (size_t)RCTX * DM;
                const f32x4 ps4 = (*(const f32x4*)pp + *(const f32x4*)(pp + ps)) + (*(const f32x4*)(pp + 2 * ps) + *(const f32x4*)(pp + 3 * ps));
                v[j] = v[j] + *(const f32x4*)(gate_c + c) * ps4; *(f32x4*)(hc_out + (size_t)(row - RLAT) * DM + c) = v[j]; }
            s += (v[j][0] * v[j][0] + v[j][1] * v[j][1]) + (v[j][2] * v[j][2] + v[j][3] * v[j][3]); }
        const float rstd = rsqrtf(wave_sum(s) * (1.0f / DM) + NORM_EPS);
#pragma unroll
        for (int j = 0; j < 4; ++j) { const int c = 4 * I.lane + 256 * j; const f32x4 a = *(const f32x4*)(sc + c), bs = *(const f32x4*)(sh + c);
            const f32x4 o = v[j] * rstd * (a + 1.0f) + bs; u32x2 w; w.x = pk2(o[0], o[1]); w.y = pk2(o[2], o[3]); *(u32x2*)(U + (size_t)row * DM + c) = w; }
    }
}
__device__ __forceinline__ void final_norm(int wave_s, float* h, const float* g) {
    const Ids I = make_ids(wave_s);
    const int gw = I.vcu * 8 + I.wave, NGW = I.G * 8;
    for (int grp = gw; grp < RLAT / 4; grp += NGW) {
        float* src = h + (size_t)grp * 4 * DM + 4 * I.lane;
        f32x4 v[4][4];
#pragma unroll
        for (int r = 0; r < 4; ++r)
#pragma unroll
            for (int j = 0; j < 4; ++j) v[r][j] = *(const f32x4*)(src + r * DM + 256 * j);
        float rstd[4];
#pragma unroll
        for (int r = 0; r < 4; ++r) { float s = 0.f;
#pragma unroll
            for (int j = 0; j < 4; ++j) s += (v[r][j][0] * v[r][j][0] + v[r][j][1] * v[r][j][1]) + (v[r][j][2] * v[r][j][2] + v[r][j][3] * v[r][j][3]);
            rstd[r] = rsqrtf(wave_sum(s) * (1.0f / DM) + NORM_EPS); }
#pragma unroll
        for (int j = 0; j < 4; ++j) { const f32x4 a = *(const f32x4*)(g + 4 * I.lane + 256 * j);
#pragma unroll
            for (int r = 0; r < 4; ++r) *(f32x4*)(src + r * DM + 256 * j) = v[r][j] * rstd[r] * a; }
    }
}
__device__ __forceinline__ void gn_rows(int wave_s, bf16_t* O, int nrows) {
    const Ids I = make_ids(wave_s);
    const int gw = I.vcu * 8 + I.wave, NGW = I.G * 8;
    for (int grp = gw; grp < nrows / 4; grp += NGW) {
        bf16_t* p0 = O + (size_t)grp * 4 * 2048 + I.lane * 8;
        u32x4 w[4][4];
#pragma unroll
        for (int r = 0; r < 4; ++r)
#pragma unroll
            for (int hd = 0; hd < 4; ++hd) w[r][hd] = *(const u32x4*)(p0 + r * 2048 + hd * 512);
#pragma unroll
        for (int r = 0; r < 4; ++r)
#pragma unroll
            for (int hd = 0; hd < 4; ++hd) {
                const u32x4 ww = w[r][hd];
                float x0 = bflo(ww.x), x1 = bfhi(ww.x), x2 = bflo(ww.y), x3 = bfhi(ww.y), x4 = bflo(ww.z), x5 = bfhi(ww.z), x6 = bflo(ww.w), x7 = bfhi(ww.w);
                const float mean = wave_sum(((x0 + x1) + (x2 + x3)) + ((x4 + x5) + (x6 + x7))) * (1.0f / 512.0f);
                x0 -= mean; x1 -= mean; x2 -= mean; x3 -= mean; x4 -= mean; x5 -= mean; x6 -= mean; x7 -= mean;
                const float var = wave_sum(((x0 * x0 + x1 * x1) + (x2 * x2 + x3 * x3)) + ((x4 * x4 + x5 * x5) + (x6 * x6 + x7 * x7))) * (1.0f / 512.0f);
                const float rstd = rsqrtf(var + 1e-5f);
                u32x4 o; o.x = pk2(x0 * rstd, x1 * rstd); o.y = pk2(x2 * rstd, x3 * rstd); o.z = pk2(x4 * rstd, x5 * rstd); o.w = pk2(x6 * rstd, x7 * rstd);
                *(u32x4*)(p0 + r * 2048 + hd * 512) = o;
            }
    }
}

__device__ __forceinline__ void ada_phase(int wave_s, LAS unsigned char* lds, const float* c, const float* cctx, const float* ada_w, const float* ada_b, float* MOD) {
    const Ids I = make_ids(wave_s);
    LAS float* sl = (LAS float*)lds;
    LAS float* red = sl + 9 * 1024;
    for (int idx = I.tid; idx < 9 * 1024; idx += 512) { const int r = idx >> 10, k = idx & 1023; const float x = r < 8 ? c[r * 1024 + k] : cctx[k]; sl[idx] = silu_f(x); }
    __syncthreads();
    const int cgx = I.tid & 7, ks = I.tid >> 3;
    for (int item = blockIdx.x; item < 4 * 192; item += gridDim.x) {
        const int l = item / 192, n0 = (item % 192) * 32;
        f32x4 a0 = {0.f, 0.f, 0.f, 0.f}, a1 = a0, a2 = a0, a3 = a0, a4 = a0, a5 = a0, a6 = a0, a7 = a0, a8 = a0;
        const float* wp = ada_w + ((size_t)l * 1024 + ks * 16) * NMODC + n0 + 4 * cgx;
        const LAS float* sp = sl + ks * 16;
#pragma unroll 8
        for (int kk = 0; kk < 16; ++kk) {
            const f32x4 w = *(const f32x4*)(wp + (size_t)kk * NMODC);
            a0 += w * sp[kk]; a1 += w * sp[1024 + kk]; a2 += w * sp[2048 + kk]; a3 += w * sp[3072 + kk]; a4 += w * sp[4096 + kk];
            a5 += w * sp[5120 + kk]; a6 += w * sp[6144 + kk]; a7 += w * sp[7168 + kk]; a8 += w * sp[8192 + kk];
        }
        LAS f32x4* rp = (LAS f32x4*)(red + (ks * 8 + cgx) * 36);
        rp[0] = a0; rp[1] = a1; rp[2] = a2; rp[3] = a3; rp[4] = a4; rp[5] = a5; rp[6] = a6; rp[7] = a7; rp[8] = a8;
        __syncthreads();
        for (int o = I.tid; o < 288; o += 512) {
            const int r = o >> 5, col = o & 31, cg2 = col >> 2, j = col & 3; float s = 0.f;
            for (int k2 = 0; k2 < 64; ++k2) s += red[(k2 * 8 + cg2) * 36 + r * 4 + j];
            MOD[(size_t)(l * 9 + r) * NMODC + n0 + col] = s + ada_b[l * NMODC + n0 + col];
        }
        __syncthreads();
    }
}
__device__ __forceinline__ void rope_tables(float* T) {
    const int g = blockIdx.x * 512 + threadIdx.x;
    if (g < 64) T[10240 + g] = exp2f(-(float)g * (1.0f / 64.0f) * 13.287712379549449f) * 0.15915494309189535f;
    if (g < 1024 + 4096) {
        int pos, j; float e; float* cp; float* sp;
        if (g < 1024) { pos = g >> 4; j = g & 15; e = (float)j * (1.0f / 16.0f); cp = T + g; sp = T + 1024 + g; }
        else { const int g2 = g - 1024; pos = g2 >> 6; j = g2 & 63; e = (float)j * (1.0f / 64.0f); cp = T + 2048 + g2; sp = T + 2048 + 4096 + g2; }
        const float inv = exp2f(-e * 13.287712379549449f);
        const float ang = (float)pos * inv;
        const float n = rintf(ang * 0.15915494309189535f);
        float r = fmaf(-n, 6.2831854820251465f, ang); r = fmaf(-n, -1.7484555e-07f, r);
        *cp = __builtin_amdgcn_cosf(r * 0.15915494309189535f); *sp = __builtin_amdgcn_sinf(r * 0.15915494309189535f);
    }
}

__device__ __forceinline__ void attn_phase(int wave_s, LAS unsigned char* lds, const bf16_t* QA, const bf16_t* KA, const bf16_t* VT, bf16_t* OA, const float* lam, const float* subg, float lambda_init, bool need_ctx) {
    const Ids I = make_ids(wave_s);
    const int tid = I.tid, lane = I.lane, wave = I.wave, r32 = lane & 31, hi = lane >> 5, map = wave >> 2, wq = wave & 3;
    float s01 = 0.f, s23 = 0.f;
    for (int d = 0; d < 64; ++d) { s01 += lam[d] * lam[64 + d]; s23 += lam[128 + d] * lam[192 + d]; }
    const float lam_full = __expf(s01) - __expf(s23) + lambda_init;
    const float osc = 1.0f - lambda_init;
    const int nunits = 2048 + (need_ctx ? 128 : 0);
    constexpr int STG = 36864;
    const int krow = tid >> 3, kch = tid & 7;
    const int kro = kappa(r32) * 144 + hi * 16;
    for (int u = I.vcu; u < nunits; u += I.G) {
        int bh, q0, key0, nt, tok0;
        if (u < 2048) { bh = u >> 5; const int qb = u & 31; q0 = qb * 128; key0 = 0; nt = KEYS / 64; tok0 = (bh >> 3) * SEQ + q0; }
        else { const int v = u - 2048; bh = v >> 1; const int qb = v & 1; q0 = SEQ + qb * 128; key0 = SEQ; nt = CTXL / 64; tok0 = RLAT + (bh >> 3) * CTXL + qb * 128; }
        const int h = bh & 7;
        const bf16_t* qp = QA + ((size_t)(bh * 2 + map) * KEYS + q0 + wq * 32 + r32) * 64 + hi * 8;
        bf16x8 qf[4];
#pragma unroll
        for (int ks = 0; ks < 4; ++ks) qf[ks] = *(const bf16x8*)(qp + ks * 16);
        const bf16_t* k0p = KA + ((size_t)(bh * 2 + 0) * KEYS + key0 + krow) * 64 + kch * 8;
        const bf16_t* k1p = KA + ((size_t)(bh * 2 + 1) * KEYS + key0 + krow) * 64 + kch * 8;
        const bf16_t* v0p = VT + ((size_t)bh * 128 + krow) * KEYS + key0 + kch * 8;
        const bf16_t* v1p = v0p + (size_t)64 * KEYS;
        const int rot = (u < 2048) ? ((u & 31) * 2) : ((u & 1) * 2);
        u32x4 sk0 = *(const u32x4*)(k0p + (size_t)rot * 4096), sk1 = *(const u32x4*)(k1p + (size_t)rot * 4096), sv0 = *(const u32x4*)(v0p + rot * 64), sv1 = *(const u32x4*)(v1p + rot * 64);
#define ATT_WRITE(stoff) do { LAS unsigned char* sb_ = lds + (stoff) + krow * 144 + kch * 16; *(LAS u32x4*)(sb_) = sk0; *(LAS u32x4*)(sb_ + 9216) = sk1; *(LAS u32x4*)(sb_ + 18432) = sv0; *(LAS u32x4*)(sb_ + 18432 + 9216) = sv1; } while (0)
#define ATT_LOAD(tt) do { sk0 = *(const u32x4*)(k0p + (size_t)(tt) * 4096); sk1 = *(const u32x4*)(k1p + (size_t)(tt) * 4096); sv0 = *(const u32x4*)(v0p + (tt) * 64); sv1 = *(const u32x4*)(v1p + (tt) * 64); } while (0)
#define ATT_QK(P0, P1, stoff) do { const LAS unsigned char* kb_ = lds + (stoff) + map * 9216 + kro; \
            _Pragma("unroll") for (int r = 0; r < 16; ++r) { P0[r] = 0.f; P1[r] = 0.f; } \
            _Pragma("unroll") for (int ks = 0; ks < 4; ++ks) { const bf16x8 a0 = *(const LAS bf16x8*)(kb_ + ks * 32), a1 = *(const LAS bf16x8*)(kb_ + 32 * 144 + ks * 32); \
                P0 = mfma32(a0, qf[ks], P0); P1 = mfma32(a1, qf[ks], P1); } } while (0)
        f32x16 O[4];
        typedef float f32x8 __attribute__((ext_vector_type(8)));
        f32x8 lv8;
        volatile LAS unsigned* aflag = (volatile LAS unsigned*)(lds + LDS_BYTES - 64);
#define ATT_TILES(FAST) \
        for (int t = 0; t < nt; ++t) { \
            const int s0 = (t & 1) * STG, s1 = STG - s0; \
            ATT_WRITE(s1); \
            { int tl = t + 2 < nt ? t + 2 : nt - 1; tl += rot; tl = tl < nt ? tl : tl - nt; ATT_LOAD(tl); } \
            f32x16 pc0, pc1; \
            ATT_QK(pc0, pc1, s0); \
            if (!(FAST) && t == 0) { float m0 = __builtin_fmaxf(pc0[0], pc1[0]); \
                _Pragma("unroll") for (int r = 1; r < 16; ++r) m0 = __builtin_fmaxf(m0, __builtin_fmaxf(pc0[r], pc1[r])); \
                mref = xor32_max(m0); } \
            const LAS unsigned char* vb = lds + s0 + 18432 + r32 * 144 + hi * 16; \
            bf16x8 vf0 = *(const LAS bf16x8*)(vb), vf1 = *(const LAS bf16x8*)(vb + 32 * 144), vf2 = *(const LAS bf16x8*)(vb + 64 * 144), vf3 = *(const LAS bf16x8*)(vb + 96 * 144); \
            if (!(FAST)) { \
                pc0 = pc0 - mref; pc1 = pc1 - mref; \
                float mx = __builtin_fmaxf(__builtin_fmaxf(pc0[0], pc1[0]), pc0[1]); \
                mx = __builtin_fmaxf(__builtin_fmaxf(mx, pc1[1]), pc0[2]); \
                _Pragma("unroll") for (int r = 2; r < 15; ++r) mx = __builtin_fmaxf(__builtin_fmaxf(mx, pc1[r]), pc0[r + 1]); \
                mx = __builtin_fmaxf(mx, pc1[15]); \
                mx = xor32_max(mx); \
                if (__any(mx > 8.0f)) { \
                    const float dl = __builtin_fmaxf(mx, 0.f); mref += dl; pc0 = pc0 - dl; pc1 = pc1 - dl; \
                    const float alpha = __builtin_amdgcn_exp2f(-dl); lv8 = lv8 * alpha; \
                    _Pragma("unroll") for (int d = 0; d < 4; ++d) O[d] = O[d] * alpha; \
                } \
            } \
            _Pragma("unroll") for (int s = 0; s < 4; ++s) { \
                bf16x8 vn0 = vf0, vn1 = vf1, vn2 = vf2, vn3 = vf3; \
                if (s < 3) { vn0 = *(const LAS bf16x8*)(vb + (s + 1) * 32); vn1 = *(const LAS bf16x8*)(vb + 32 * 144 + (s + 1) * 32); vn2 = *(const LAS bf16x8*)(vb + 64 * 144 + (s + 1) * 32); vn3 = *(const LAS bf16x8*)(vb + 96 * 144 + (s + 1) * 32); } \
                f32x8 e; \
                _Pragma("unroll") for (int j = 0; j < 8; ++j) e[j] = __builtin_amdgcn_exp2f(s < 2 ? pc0[8 * s + j] : pc1[8 * (s - 2) + j]); \
                lv8 = lv8 + e; \
                u32x4 w; w.x = pk2(e[0], e[1]); w.y = pk2(e[2], e[3]); w.z = pk2(e[4], e[5]); w.w = pk2(e[6], e[7]); \
                const bf16x8 pb = __builtin_bit_cast(bf16x8, w); \
                O[0] = mfma32(vf0, pb, O[0]); O[1] = mfma32(vf1, pb, O[1]); O[2] = mfma32(vf2, pb, O[2]); O[3] = mfma32(vf3, pb, O[3]); \
                vf0 = vn0; vf1 = vn1; vf2 = vn2; vf3 = vn3; \
            } \
            __syncthreads(); \
        }
        float lsum = 0.f;
        for (int pass = 0; pass < 2; ++pass) {
            if (pass == 1) ATT_LOAD(rot);
            ATT_WRITE(0);
            ATT_LOAD(rot + 1 < nt ? rot + 1 : rot + 1 - nt);
            __syncthreads();
#pragma unroll
            for (int d = 0; d < 4; ++d)
#pragma unroll
                for (int r = 0; r < 16; ++r) O[d][r] = 0.f;
#pragma unroll
            for (int r = 0; r < 8; ++r) lv8[r] = 0.f;
            float mref = 0.f;
            if (pass == 0) { ATT_TILES(true) } else { ATT_TILES(false) }
            lsum = xor32_sum(((lv8[0] + lv8[1]) + (lv8[2] + lv8[3])) + ((lv8[4] + lv8[5]) + (lv8[6] + lv8[7])));
            if (pass == 1) break;
            const bool bad = !(lsum > 1e-30f && lsum < 1e30f);
            const unsigned wbad = __any(bad) ? 1u : 0u;
            if (lane == 0) aflag[wave] = wbad;
            __syncthreads();
            const unsigned any8 = aflag[0] | aflag[1] | aflag[2] | aflag[3] | aflag[4] | aflag[5] | aflag[6] | aflag[7];
            __syncthreads();
            if (any8 == 0u) break;
        }
#undef ATT_TILES
#undef ATT_WRITE
#undef ATT_LOAD
#undef ATT_QK
        const float inv = 1.0f / lsum;
        LAS float* X = (LAS float*)lds;
        const int xr = wq * 32 + r32;
        if (map == 1) {
#pragma unroll
            for (int d = 0; d < 4; ++d)
#pragma unroll
                for (int g = 0; g < 4; ++g) { f32x4 v = {O[d][4 * g] * inv, O[d][4 * g + 1] * inv, O[d][4 * g + 2] * inv, O[d][4 * g + 3] * inv}; *(LAS f32x4*)(X + xr * 132 + 32 * d + 8 * g + 4 * hi) = v; }
        }
        __syncthreads();
        if (map == 0) {
            float ss = 0.f;
#pragma unroll
            for (int d = 0; d < 4; ++d)
#pragma unroll
                for (int g = 0; g < 4; ++g) { const f32x4 o1 = *(const LAS f32x4*)(X + xr * 132 + 32 * d + 8 * g + 4 * hi);
#pragma unroll
                    for (int j = 0; j < 4; ++j) { const float df = O[d][4 * g + j] * inv - lam_full * o1[j]; O[d][4 * g + j] = df; ss += df * df; } }
            ss = xor32_sum(ss);
            const float rn = rsqrtf(ss * (1.0f / 128.0f) + NORM_EPS) * osc;
            bf16_t* op = OA + (size_t)(tok0 + xr) * DM + h * 128 + 4 * hi;
#pragma unroll
            for (int d = 0; d < 4; ++d)
#pragma unroll
                for (int g = 0; g < 4; ++g) { const int cdv = 32 * d + 8 * g; const f32x4 gg = *(const f32x4*)(subg + cdv + 4 * hi);
                    u32x2 w; w.x = pk2(O[d][4 * g] * rn * gg[0], O[d][4 * g + 1] * rn * gg[1]); w.y = pk2(O[d][4 * g + 2] * rn * gg[2], O[d][4 * g + 3] * rn * gg[3]);
                    *(u32x2*)(op + cdv) = w; }
        }
        __syncthreads();
    }
}

constexpr int SC_QD = 0, SC_KD = 18432, SC_BUF = 36864, SC_SQ = 0, SC_VS = 73728, SC_ST = 92160, SC_END = 125952;
static_assert(SC_END <= LDS_BYTES, "scan LDS map");
__device__ __forceinline__ int scan_row0(int step, int dir, int b) {
    if (step < 2) { const int c = dir == 0 ? step : 1 - step; return RLAT + b * CTXL + c * 128; }
    const int c = dir == 0 ? step - 2 : 33 - step; return b * SEQ + c * 128;
}
typedef short s16x4_t __attribute__((ext_vector_type(4)));
__device__ __forceinline__ bf16x8 tr_frag(const LAS unsigned char* p) {
    const s16x4_t lo = __builtin_bit_cast(s16x4_t, __builtin_amdgcn_ds_read_tr16_b64_v4i16((LAS s16x4_t*)p));
    const s16x4_t hi = __builtin_bit_cast(s16x4_t, __builtin_amdgcn_ds_read_tr16_b64_v4i16((LAS s16x4_t*)(p + 4 * 144)));
    return (bf16x8){lo[0], lo[1], lo[2], lo[3], hi[0], hi[1], hi[2], hi[3]};
}
__device__ __forceinline__ void st16(LAS unsigned char* p, unsigned v) { *(LAS unsigned short*)p = (unsigned short)v; }
__device__ __forceinline__ void tr_write8(LAS unsigned char* base, u32x4 w) {
    st16(base, w.x & 0xffffu); st16(base + 272, w.x >> 16); st16(base + 2 * 272, w.y & 0xffffu); st16(base + 3 * 272, w.y >> 16);
    st16(base + 4 * 272, w.z & 0xffffu); st16(base + 5 * 272, w.z >> 16); st16(base + 6 * 272, w.w & 0xffffu); st16(base + 7 * 272, w.w >> 16);
}
__device__ __forceinline__ void scan_phase(int wave_s, LAS unsigned char* lds, const bf16_t* QR, const bf16_t* KR, const bf16_t* VR, bf16_t* O, const float* dlogit) {
    const Ids I = make_ids(wave_s);
    const int tid = I.tid, lane = I.lane, wave = I.wave, r32 = lane & 31, hi = lane >> 5;
    const int qb = wave & 3, dvb = wave >> 2, sdv = wave & 1, sdb0 = wave >> 1;
    const int srow = tid >> 3, sch = tid & 7;
    const int qloc = 32 * qb + r32;
    const int trb = (hi * 8 + ((lane & 15) >> 2)) * 144 + (((lane >> 4) & 1) * 16 + (lane & 3) * 4) * 2;
    for (int u = I.vcu; u < 256; u += I.G) {
        const int slice = u & 7, h = (u >> 3) & 3, b = u >> 5;
        for (int dir = 0; dir < 2; ++dir) {
            const float lg2 = -__log2f(1.0f + __expf(-dlogit[dir * 4 + h]));
            const float gC = exp2f(128.0f * lg2);
            const float e0 = dir == 0 ? (float)(127 - srow) : (float)srow, e1 = dir == 0 ? (float)(63 - srow) : (float)(srow + 64);
            const float vz0 = exp2f(lg2 * e0), vz1 = exp2f(lg2 * e1);
            const float fin = exp2f(lg2 * (dir == 0 ? (float)(qloc - 127) : (float)(-qloc)));
            for (int i = tid; i < (SC_END - SC_ST) / 16; i += 512) *(LAS u32x4*)(lds + SC_ST + i * 16) = (u32x4){0u, 0u, 0u, 0u};
            f32x16 st0, st1, sa0, sa1, ca;
#pragma unroll
            for (int r = 0; r < 16; ++r) { st0[r] = 0.f; st1[r] = 0.f; sa0[r] = 0.f; sa1[r] = 0.f; ca[r] = 0.f; }
            int row0 = scan_row0(0, dir, b);
            const size_t qoff = (size_t)srow * 1024 + h * 256 + sch * 8, voff = (size_t)srow * 2048 + h * 512 + slice * 64 + sch * 8;
            u32x4 gq0, gq1, gk0, gk1, gv0, gv1, go0 = {0u, 0u, 0u, 0u}, go1 = go0;
            { const bf16_t* qp = QR + (size_t)row0 * 1024 + qoff; const bf16_t* kp = KR + (size_t)row0 * 1024 + qoff; const bf16_t* vp = VR + (size_t)row0 * 2048 + voff;
              gq0 = *(const u32x4*)qp; gq1 = *(const u32x4*)(qp + 64 * 1024); gk0 = *(const u32x4*)kp; gk1 = *(const u32x4*)(kp + 64 * 1024); gv0 = *(const u32x4*)vp; gv1 = *(const u32x4*)(vp + 64 * 2048); }
            for (int step = 0; step < 34; ++step) {
                const int row_next = scan_row0(step + 1 < 34 ? step + 1 : step, dir, b);
#pragma unroll
                for (int dc = 0; dc < 4; ++dc) {
                    { const u32x4 a0 = gq0, a1 = gq1, b0 = gk0, b1 = gk1;
                      LAS unsigned char* qd = lds + (dc & 1) * SC_BUF + SC_QD + srow * 144 + sch * 16; *(LAS u32x4*)qd = a0; *(LAS u32x4*)(qd + 64 * 144) = a1;
                      LAS unsigned char* kd = lds + (dc & 1) * SC_BUF + SC_KD + srow * 144 + sch * 16; *(LAS u32x4*)kd = b0; *(LAS u32x4*)(kd + 64 * 144) = b1;
                      if (dc == 0) { LAS unsigned char* vd = lds + SC_VS + srow * 144 + sch * 16; *(LAS u32x4*)vd = scale8(gv0, vz0); *(LAS u32x4*)(vd + 64 * 144) = scale8(gv1, vz1); } }
                    __syncthreads();
                    if (dc == 0 && dir == 1) { const bf16_t* op = O + (size_t)(row0 + srow) * 2048 + h * 512 + slice * 64 + sch * 8; go0 = *(const u32x4*)op; go1 = *(const u32x4*)(op + (size_t)64 * 2048); }
                    if (dc < 3) { const bf16_t* qp = QR + (size_t)row0 * 1024 + qoff + (dc + 1) * 64; const bf16_t* kp = KR + (size_t)row0 * 1024 + qoff + (dc + 1) * 64;
                        gq0 = *(const u32x4*)qp; gq1 = *(const u32x4*)(qp + 64 * 1024); gk0 = *(const u32x4*)kp; gk1 = *(const u32x4*)(kp + 64 * 1024); }
                    else { const bf16_t* qp = QR + (size_t)row_next * 1024 + qoff; const bf16_t* kp = KR + (size_t)row_next * 1024 + qoff; const bf16_t* vp = VR + (size_t)row_next * 2048 + voff;
                        gq0 = *(const u32x4*)qp; gq1 = *(const u32x4*)(qp + 64 * 1024); gk0 = *(const u32x4*)kp; gk1 = *(const u32x4*)(kp + 64 * 1024); gv0 = *(const u32x4*)vp; gv1 = *(const u32x4*)(vp + 64 * 2048); }
                    bf16x8 bq[4];
#pragma unroll
                    for (int ks = 0; ks < 4; ++ks) bq[ks] = *(const LAS bf16x8*)(lds + (dc & 1) * SC_BUF + SC_QD + qloc * 144 + ks * 32 + hi * 16);
#pragma unroll
                    for (int ks = 0; ks < 4; ++ks) {
                        const bf16x8 k0 = *(const LAS bf16x8*)(lds + (dc & 1) * SC_BUF + SC_KD + (64 * dvb + kappa(r32)) * 144 + ks * 32 + hi * 16);
                        const bf16x8 k1 = *(const LAS bf16x8*)(lds + (dc & 1) * SC_BUF + SC_KD + (64 * dvb + 32 + kappa(r32)) * 144 + ks * 32 + hi * 16);
                        const bf16x8 sf = *(const LAS bf16x8*)(lds + SC_ST + (32 * dvb + r32) * 528 + (64 * dc + 16 * ks + 8 * hi) * 2);
                        sa0 = mfma32(k0, bq[ks], sa0); sa1 = mfma32(k1, bq[ks], sa1); ca = mfma32(sf, bq[ks], ca);
                    }
                    if ((dc & 1) == dvb) {
                        f32x16 s = (dc < 2) ? st0 : st1;
                        s = s * gC;
                        const LAS unsigned char* ka = lds + (dc & 1) * SC_BUF + SC_KD + trb + (sdb0 & 1) * 64;
                        const LAS unsigned char* va = lds + SC_VS + trb + sdv * 64;
                        f32x16 s2;
#pragma unroll
                        for (int r = 0; r < 16; ++r) s2[r] = 0.f;
#pragma unroll
                        for (int ks = 0; ks < 8; ks += 2) { const bf16x8 a = tr_frag(ka + ks * 16 * 144), bv = tr_frag(va + ks * 16 * 144), a2 = tr_frag(ka + (ks + 1) * 16 * 144), bv2 = tr_frag(va + (ks + 1) * 16 * 144);
                            s = mfma32(a, bv, s); s2 = mfma32(a2, bv2, s2); }
                        s = s + s2;
                        if (dc < 2) st0 = s; else st1 = s;
                    }
                }
#pragma unroll
                for (int x = 0; x < 2; ++x)
#pragma unroll
                    for (int s2 = 0; s2 < 2; ++s2) {
                        const int key0 = 64 * dvb + 32 * x + 16 * s2 + 8 * hi; float v[8];
#pragma unroll
                        for (int e = 0; e < 8; ++e) { const float sv = x == 0 ? sa0[8 * s2 + e] : sa1[8 * s2 + e]; const bool keep = dir == 0 ? (key0 + e <= qloc) : (key0 + e > qloc); v[e] = keep ? sv : 0.f; }
                        u32x4 w; w.x = pk2(v[0], v[1]); w.y = pk2(v[2], v[3]); w.z = pk2(v[4], v[5]); w.w = pk2(v[6], v[7]);
                        *(LAS u32x4*)(lds + SC_SQ + qloc * 272 + key0 * 2) = w;
                    }
                ca = ca * gC;
                __syncthreads();
#pragma unroll
                for (int x = 0; x < 2; ++x)
#pragma unroll
                    for (int g = 0; g < 4; ++g) { const int d = 32 * (sdb0 + 4 * x) + 8 * g + 4 * hi; u32x2 w;
                        if (x == 0) { w.x = pk2(st0[4 * g], st0[4 * g + 1]); w.y = pk2(st0[4 * g + 2], st0[4 * g + 3]); } else { w.x = pk2(st1[4 * g], st1[4 * g + 1]); w.y = pk2(st1[4 * g + 2], st1[4 * g + 3]); }
                        *(LAS u32x2*)(lds + SC_ST + (32 * sdv + r32) * 528 + d * 2) = w; }
                { const LAS unsigned char* va = lds + SC_VS + trb + dvb * 64;
                  f32x16 c2;
#pragma unroll
                  for (int r = 0; r < 16; ++r) c2[r] = 0.f;
#pragma unroll
                  for (int ks = 0; ks < 8; ks += 2) { const bf16x8 a = tr_frag(va + ks * 16 * 144), a2 = tr_frag(va + (ks + 1) * 16 * 144);
                      const bf16x8 bs = *(const LAS bf16x8*)(lds + SC_SQ + qloc * 272 + ks * 32 + hi * 16), bs2 = *(const LAS bf16x8*)(lds + SC_SQ + qloc * 272 + (ks + 1) * 32 + hi * 16);
                      ca = mfma32(a, bs, ca); c2 = mfma32(a2, bs2, c2); }
                  ca = ca + c2; }
#pragma unroll
                for (int g = 0; g < 4; ++g) { const f32x4 v = {ca[4 * g] * fin, ca[4 * g + 1] * fin, ca[4 * g + 2] * fin, ca[4 * g + 3] * fin}; *(LAS f32x4*)(lds + SC_BUF + qloc * 272 + (32 * dvb + 8 * g + 4 * hi) * 4) = v; }
#pragma unroll
                for (int r = 0; r < 16; ++r) { sa0[r] = 0.f; sa1[r] = 0.f; ca[r] = 0.f; }
                __syncthreads();
                { bf16_t* op = O + (size_t)(row0 + srow) * 2048 + h * 512 + slice * 64 + sch * 8;
                  const LAS unsigned char* os = lds + SC_BUF + srow * 272 + sch * 32;
                  f32x4 x0 = *(const LAS f32x4*)os, x1 = *(const LAS f32x4*)(os + 16), y0 = *(const LAS f32x4*)(os + 64 * 272), y1 = *(const LAS f32x4*)(os + 64 * 272 + 16);
                  if (dir == 1) {
                      x0[0] += bflo(go0.x); x0[1] += bfhi(go0.x); x0[2] += bflo(go0.y); x0[3] += bfhi(go0.y); x1[0] += bflo(go0.z); x1[1] += bfhi(go0.z); x1[2] += bflo(go0.w); x1[3] += bfhi(go0.w);
                      y0[0] += bflo(go1.x); y0[1] += bfhi(go1.x); y0[2] += bflo(go1.y); y0[3] += bfhi(go1.y); y1[0] += bflo(go1.z); y1[1] += bfhi(go1.z); y1[2] += bflo(go1.w); y1[3] += bfhi(go1.w); }
                  *(u32x4*)op = pack8(x0, x1); *(u32x4*)(op + (size_t)64 * 2048) = pack8(y0, y1); }
                row0 = row_next;
            }
        }
    }
}

#define XB_TMO      128
#define XB_XCNT(j)  (256  + 64 * (j))
#define XB_XSUB(j)  (1280 + 64 * (j))
#define XB_XGEN(j)  (2304 + 64 * (j))
#define XB_TOP      3328
#define XB_TOPGEN   3392
#define XCD_BAR_WORDS 3456
#define XB_SPIN_CAP (1u << 21)

__device__ __forceinline__ unsigned xb_ld(unsigned* p)              { return __hip_atomic_load(p, __ATOMIC_RELAXED, __HIP_MEMORY_SCOPE_AGENT); }
__device__ __forceinline__ unsigned xb_add(unsigned* p, unsigned v) { return __hip_atomic_fetch_add(p, v, __ATOMIC_RELAXED, __HIP_MEMORY_SCOPE_AGENT); }
__device__ __forceinline__ unsigned xb_xcc_id() { return (unsigned)__builtin_amdgcn_s_getreg((3 << 11) | 20) & 0xFu; }
#define XB_SPIN(cond, bar) do { unsigned _sp = 0; while (cond) {   \
    if ((++_sp & 255u) == 0u) { if (xb_ld(&(bar)[XB_TMO])) break; if (_sp > XB_SPIN_CAP) { atomicAdd(&(bar)[XB_TMO], 1u); break; } } } } while (0)

struct XcdBarrier {
    unsigned* bar; unsigned x;
    bool w0;
    volatile LAS unsigned* st;
};

__device__ __forceinline__ XcdBarrier xcd_barrier_post(unsigned* bar, volatile LAS unsigned* st) {
    XcdBarrier b; b.bar = bar; b.x = xb_xcc_id(); b.st = st;
    if (threadIdx.x == 0) (void)xb_add(&bar[XB_XCNT(b.x)], 1u);
    return b;
}
__device__ __forceinline__ void xcd_barrier_complete(unsigned* bar, unsigned x, unsigned& nloc, unsigned& nx) {
    const unsigned G = gridDim.x * gridDim.y * gridDim.z;
    unsigned sum, cnt, mine, sp = 0u;
    for (;;) {
        sum = 0u; cnt = 0u; mine = 0u;
#pragma unroll
        for (unsigned j = 0; j < 16; ++j) { const unsigned c = xb_ld(&bar[XB_XCNT(j)]); sum += c; cnt += (c > 0u) ? 1u : 0u; mine = (j == x) ? c : mine; }
        if (sum == G) break;
        __builtin_amdgcn_s_sleep(1);
        if ((++sp & 255u) == 0u) { if (xb_ld(&bar[XB_TMO])) break; if (sp > XB_SPIN_CAP) { atomicAdd(&bar[XB_TMO], 1u); break; } }
    }
    nloc = mine > 0u ? mine : 1u; nx = cnt > 0u ? cnt : 1u;
}

__device__ __forceinline__ void xcd_barrier(const XcdBarrier& b) {
    asm volatile("s_waitcnt vmcnt(0)" ::: "memory");
    __syncthreads();
    if (b.w0 && hw_lane() == 0) {
        unsigned* bar = b.bar;
        __builtin_amdgcn_s_waitcnt(0);
        unsigned nloc = b.st[0], nx = b.st[1];
        const unsigned old = xb_add(&bar[XB_XSUB(b.x)], 1u);
        const unsigned gen = old / nloc;
        if (old + 1u == (gen + 1u) * nloc) {
            __builtin_amdgcn_fence(__ATOMIC_RELEASE, "agent");
            asm volatile("s_waitcnt vmcnt(0)" ::: "memory");
            const unsigned og = xb_add(&bar[XB_TOP], 1u);
            const unsigned tg = og / nx;
            if (og + 1u == (tg + 1u) * nx) xb_add(&bar[XB_TOPGEN], 1u);
            else XB_SPIN(xb_ld(&bar[XB_TOPGEN]) == tg, bar);
            __builtin_amdgcn_fence(__ATOMIC_ACQUIRE, "agent");
            xb_add(&bar[XB_XGEN(b.x)], 1u);
            asm volatile("s_waitcnt vmcnt(0)" ::: "memory");
        } else {
            XB_SPIN(xb_ld(&bar[XB_XGEN(b.x)]) == gen, bar);
            __builtin_amdgcn_fence(__ATOMIC_ACQUIRE, "agent");
            asm volatile("s_waitcnt vmcnt(0)" ::: "memory");
        }
    }
    __syncthreads();
}

struct Args { const float* in[16]; float* out; unsigned char* ws; };
__global__ void __launch_bounds__(512, 2) mega_fwd(Args a) {
    extern __shared__ __attribute__((aligned(16))) unsigned char lds_raw[];
    LAS unsigned char* lds = (LAS unsigned char*)lds_raw;
    cg::grid_group grid = cg::this_grid();
    const int wave_s = __builtin_amdgcn_readfirstlane((int)threadIdx.x >> 6);
    volatile LAS unsigned* bst = (volatile LAS unsigned*)(lds + LDS_BYTES - 16);
    if (threadIdx.x == 0) { bst[0] = 0u; bst[1] = 0u; }
    __syncthreads();
    XcdBarrier bar = xcd_barrier_post((unsigned*)(a.ws + WS_BAR), bst);
    bar.w0 = wave_s == 0;
#define GSYNC() xcd_barrier(bar)
    const float* x = a.in[0]; const float* cvec = a.in[1]; const float* ctx = a.in[2]; const float* cctx = a.in[3]; const float* ada_w = a.in[4]; const float* ada_b = a.in[5];
    const float* w_qkv = a.in[6]; const float* w_ao = a.in[7]; const float* a_lam = a.in[8]; const float* a_subg = a.in[9]; const float* w_rin = a.in[10]; const float* w_ro = a.in[11];
    const float* r_decay = a.in[12]; const float* w_m1 = a.in[13]; const float* w_m2 = a.in[14]; const float* fin_g = a.in[15];
    float* out = a.out; unsigned char* ws = a.ws;
    float* MOD = (float*)(ws + WS_MOD); float* ROPE = (float*)(ws + WS_ROPE);
    bf16_t* WB = (bf16_t*)(ws + WS_W); bf16_t* U = (bf16_t*)(ws + WS_U); bf16_t* QB = (bf16_t*)(ws + WS_Q); bf16_t* KB = (bf16_t*)(ws + WS_K);
    bf16_t* VB = (bf16_t*)(ws + WS_V); bf16_t* OB = (bf16_t*)(ws + WS_O); float* HC = (float*)(ws + WS_HC); bf16_t* HID = (bf16_t*)(ws + WS_HID);
    bf16_t* W1T = QB; bf16_t* W2T = QB + (size_t)DFF * DM;
    float* PART = (float*)(ws + WS_Q + 16 * MiB);

    ada_phase(wave_s, lds, cvec, cctx, ada_w, ada_b, MOD);
    rope_tables(ROPE);
    conv_two(wave_s, lds, w_qkv, DM, 3 * DM, WB, 1, w_ao, DM, DM, WB + (size_t)3 * DM * DM, (int)gridDim.x / 2);
    if (threadIdx.x == 0) { unsigned nloc_, nx_; xcd_barrier_complete(bar.bar, bar.x, nloc_, nx_); bst[0] = nloc_; bst[1] = nx_; }
    __syncthreads();
    if (a.ws == nullptr) grid.sync();
    GSYNC();

    for (int layer = 0; layer < DEPTH; ++layer) {
        const bool is_ret = (layer & 1) != 0; const int j = layer >> 1;
        const bool need_ctx = layer < DEPTH - 1;
        const int Mres = need_ctx ? RALL : RLAT;
        const float* hl_in = layer == 0 ? x : out; const float* hc_in = layer == 0 ? ctx : HC;
        const float* modL = MOD + (size_t)layer * 9 * NMODC;
        EpiP ep{};
        if (layer == 0) norm_rows(wave_s, hl_in, hc_in, modL, 0, DM, U, RALL);
        else norm_rows(wave_s, hl_in, hc_in, modL, 0, DM, U, RALL, PART, MOD + ((size_t)(layer - 1) * 9 + 8) * NMODC + 5 * DM, HC);
        if (!is_ret) { if (layer > 0) conv_two(wave_s, lds, w_qkv + (size_t)j * DM * 3 * DM, DM, 3 * DM, WB, 1, w_ao + (size_t)j * DM * DM, DM, DM, WB + (size_t)3 * DM * DM); }
        else conv_two(wave_s, lds, w_rin + (size_t)j * DM * 6 * DM, DM, 6 * DM, WB, 2, w_ro + (size_t)j * 2 * DM * DM, 2 * DM, DM, WB + (size_t)6 * DM * DM);
        GSYNC();
        if (!is_ret) {
            ep.o0 = QB; ep.o1 = KB; ep.o2 = VB; ep.rc = ROPE; ep.rs = ROPE + 1024;
            run_gemm<0>(wave_s, lds, U, WB, RALL, 3 * DM, DM, ep);
            GSYNC();
            const float lambda_init = layer == 0 ? 0.2f : 0.47071301834358397f;
            attn_phase(wave_s, lds, QB, KB, VB, OB, a_lam + j * 256, a_subg + j * 128, lambda_init, need_ctx);
            GSYNC();
            ep.hin_l = hl_in; ep.hin_c = hc_in; ep.hout_l = out; ep.hout_c = HC; ep.gate = modL + 2 * DM;
            ep.part = PART;
            run_gemm<2>(wave_s, lds, OB, WB + (size_t)3 * DM * DM, Mres, DM, DM, ep, need_ctx);
        } else {
            ep.o0 = QB; ep.o1 = KB; ep.o2 = VB; ep.rc = ROPE + 10240; ep.rs = ROPE + 10240;
            run_gemm<1>(wave_s, lds, U, WB, RALL, 4 * DM, DM, ep);
            GSYNC();
            scan_phase(wave_s, lds, QB, KB, VB, OB, r_decay + j * 8);
            GSYNC();
            gn_rows(wave_s, OB, Mres);
            GSYNC();
            ep.o0 = OB;
            run_gemm<4>(wave_s, lds, U, WB + (size_t)4 * DM * DM, Mres, 2 * DM, DM, ep);
            GSYNC();
            ep.hin_l = hl_in; ep.hin_c = hc_in; ep.hout_l = out; ep.hout_c = HC; ep.gate = modL + 2 * DM;
            ep.part = PART;
            run_gemm<2>(wave_s, lds, OB, WB + (size_t)6 * DM * DM, Mres, DM, 2 * DM, ep, need_ctx);
        }
        GSYNC();
        if (need_ctx) norm_rows(wave_s, out, hc_in, modL, 3 * DM, 4 * DM, U, Mres, PART, modL + 8 * NMODC + 2 * DM, HC);
        else norm_rows(wave_s, out, HC, modL, 3 * DM, 4 * DM, U, Mres);
        conv_two(wave_s, lds, w_m1 + (size_t)layer * DM * DFF, DM, DFF, W1T, 0, w_m2 + (size_t)layer * DFF * DM, DFF, DM, W2T);
        GSYNC();
        ep.o0 = HID;
        run_gemm<3>(wave_s, lds, U, W1T, Mres, DFF, DM, ep);
        GSYNC();
        ep.hin_l = out; ep.hin_c = HC; ep.hout_l = out; ep.hout_c = HC; ep.gate = modL + 5 * DM;
        ep.part = PART;
        run_gemm<2>(wave_s, lds, HID, W2T, Mres, DM, DFF, ep, need_ctx);
        GSYNC();
    }
    final_norm(wave_s, out, fin_g);
}

extern "C" void kernel_launch(void* const* d_in, const int* in_sizes, int n_in, void* d_out, int out_size, void* d_ws, size_t ws_size, hipStream_t stream) {
    static int grid = 0;
    if (grid == 0) {
        if (n_in != 16 || in_sizes[0] != RLAT * DM || out_size != RLAT * DM || ws_size < WS_END) {
            fprintf(stderr, "kernel_launch: unexpected shapes (n_in %d, in0 %d, out %d, ws %zu < %zu); nothing launched\n", n_in, n_in > 0 ? in_sizes[0] : -1, out_size, ws_size, (size_t)WS_END); grid = -1; return; }
        int dev = 0, cus = 0, per_cu = 0;
        if (hipGetDevice(&dev) != hipSuccess || hipDeviceGetAttribute(&cus, hipDeviceAttributeMultiprocessorCount, dev) != hipSuccess) { fprintf(stderr, "kernel_launch: device query failed\n"); grid = -1; return; }
        if (hipFuncSetAttribute((const void*)mega_fwd, hipFuncAttributeMaxDynamicSharedMemorySize, LDS_BYTES) != hipSuccess) { fprintf(stderr, "kernel_launch: hipFuncSetAttribute failed\n"); grid = -1; return; }
        if (hipOccupancyMaxActiveBlocksPerMultiprocessor(&per_cu, (const void*)mega_fwd, 512, LDS_BYTES) != hipSuccess || per_cu < 1) { fprintf(stderr, "kernel_launch: occupancy query says %d blocks per CU\n", per_cu); per_cu = 1; }
        (void)hipGetLastError();
        grid = cus;
    }
    if (grid < 0) return;
    Args a{};
    for (int i = 0; i < 16; ++i) a.in[i] = (const float*)d_in[i];
    a.out = (float*)d_out; a.ws = (unsigned char*)d_ws;
    if (hipMemsetAsync((unsigned char*)d_ws + WS_BAR, 0, 16384, stream) != hipSuccess) { fprintf(stderr, "kernel_launch: hipMemsetAsync failed\n"); return; }
    void* args[] = {&a};
    const hipError_t e = hipLaunchCooperativeKernel((const void*)mega_fwd, dim3(grid), dim3(512), args, LDS_BYTES, stream);
    if (e != hipSuccess) fprintf(stderr, "kernel_launch: cooperative launch failed: %s (grid %d)\n", hipGetErrorString(e), grid);
}
```
